# Optimizing an MI355X kernel written in HIP

```python
import jax, jax.numpy as jnp
from jax import lax
import numpy as np

D_MODEL = 1024
BATCH = 16
SEQ = 2048
DEPTH = 2

GRID_W = 64
CTX_LEN = 256
N_AB = (DEPTH + 1) // 2
N_CD = DEPTH // 2

FNET_GROUP_DIM = 64
FNET_WIDTH = D_MODEL // 4
FNET_GROUPS = FNET_WIDTH // FNET_GROUP_DIM
RWKV_HEAD_DIM = 64
RWKV_WIDTH = D_MODEL - FNET_WIDTH
RWKV_HEADS = RWKV_WIDTH // RWKV_HEAD_DIM
RWKV_DECAY_RANK = 64
RWKV_AIC_RANK = 64
RWKV_GATE_RANK = 128
RWKV_SHIFT_WIDTH = 3 * RWKV_WIDTH + 2 * RWKV_DECAY_RANK + 2 * RWKV_AIC_RANK + RWKV_GATE_RANK
RWKV_GN_EPS = 64e-5
AB_IN = FNET_WIDTH + RWKV_SHIFT_WIDTH
RET_QK_DIM = 64
RET_V_DIM = 128
RET_V_WIDTH = 3 * D_MODEL // 4
RET_HEADS = RET_V_WIDTH // RET_V_DIM
RET_QK_WIDTH = RET_HEADS * RET_QK_DIM
RET_CHUNK = 128
RET_GN_EPS = 1e-5
ROPE_BASE = 10000.0
CONV_CH = D_MODEL - RET_V_WIDTH
CONV_WIDTH = 31
CD_IN = 2 * RET_QK_WIDTH + 2 * RET_V_WIDTH + 2 * CONV_CH
D_FF = ((8 * D_MODEL + 3 * 256 - 1) // (3 * 256)) * 256

kernel_name = 'hybrid_fnet_rwkv7_retnet_conformer_dit'


def rms_norm(x, g, eps=1e-6):
    xf = x.astype(jnp.float32)
    y = xf * lax.rsqrt(jnp.mean(jnp.square(xf), axis=-1, keepdims=True) + eps)
    return (y * g.astype(jnp.float32)).astype(x.dtype)


def layer_norm(x, g, b, eps=1e-5):
    xf = x.astype(jnp.float32)
    mu = jnp.mean(xf, axis=-1, keepdims=True)
    var = jnp.mean(jnp.square(xf - mu), axis=-1, keepdims=True)
    return (xf - mu) * lax.rsqrt(var + eps) * g + b


def head_group_norm(y, g, b, eps):
    mu = jnp.mean(y, axis=-1, keepdims=True)
    var = jnp.mean(jnp.square(y - mu), axis=-1, keepdims=True)
    yn = ((y - mu) * lax.rsqrt(var + eps)).reshape(y.shape[:2] + (-1,))
    return yn * g + b


def modulate(h, shift, scale):
    return h * (1.0 + scale) + shift


def split_cols(u, widths):
    return jnp.split(u, np.cumsum(widths)[:-1].tolist(), axis=-1)


def swiglu(h, w1, w3, w2):
    return (jax.nn.silu(h @ w1) * (h @ w3)) @ w2


def axial_rope(n_tokens, dim):
    rows = n_tokens // GRID_W
    row = jnp.repeat(jnp.arange(rows, dtype=jnp.float32), GRID_W)
    col = jnp.tile(jnp.arange(GRID_W, dtype=jnp.float32), rows)
    n_freq = dim // 4
    freqs = ROPE_BASE ** (-jnp.arange(n_freq, dtype=jnp.float32) / n_freq)
    ang = jnp.concatenate([row[:, None] * freqs, col[:, None] * freqs], axis=-1)
    return jnp.cos(ang), jnp.sin(ang)


def apply_rope(t, cos, sin):
    t1, t2 = jnp.split(t, 2, axis=-1)
    c = cos[None, :, None, :]
    s = sin[None, :, None, :]
    return jnp.concatenate([t1 * c - t2 * s, t1 * s + t2 * c], axis=-1)


def fourier_mix(u):
    b, l, _ = u.shape
    ug = u.astype(jnp.float32).reshape(b, l, FNET_GROUPS, FNET_GROUP_DIM)
    f = jnp.fft.fftn(ug, axes=(1, 3), norm='ortho').real
    return f.reshape(b, l, FNET_WIDTH)


def centred_shift(u, mu_prev, mu_next):
    zero = jnp.zeros_like(u[:, :1])
    prev = jnp.concatenate([zero, u[:, :-1]], axis=1)
    nxt = jnp.concatenate([u[:, 1:], zero], axis=1)
    return u + mu_prev * (prev - u) + mu_next * (nxt - u)


def rwkv7_features(u, mu_prev, mu_next, w0, w2, a0, a2, k_k, k_a):
    u = centred_shift(u, mu_prev, mu_next).astype(jnp.float32)
    r, k, v, wl_f, wl_b, al_f, al_b, gl = split_cols(u, [RWKV_WIDTH] * 3 + [RWKV_DECAY_RANK] * 2 + [RWKV_AIC_RANK] * 2 + [RWKV_GATE_RANK])
    shp = u.shape[:2] + (RWKV_HEADS, RWKV_HEAD_DIM)
    kk = (k * k_k).reshape(shp)
    kk = kk * lax.rsqrt(jnp.sum(jnp.square(kk), axis=-1, keepdims=True) + 1e-12)
    dirs = []
    for d, (wl, al) in enumerate(((wl_f, al_f), (wl_b, al_b))):
        wlog = -jax.nn.softplus(-(w0[d] + jnp.tanh(wl) @ w2[d])) - 0.5
        decay = jnp.exp(-jnp.exp(wlog))
        a = jax.nn.sigmoid(a0[d] + al @ a2[d])
        kd = k * (1.0 + (a - 1.0) * k_a)
        dirs.append((decay.reshape(shp), kd.reshape(shp), kk * a.reshape(shp)))
    return r.reshape(shp), v.reshape(shp), kk, dirs, gl


def rwkv7_scan(r, w, k, v, kk, b, state0, reverse, emit):
    def step(S, inp):
        r_t, w_t, k_t, v_t, kk_t, b_t = inp
        S_new = (S * w_t[:, :, None, :]
                 - jnp.einsum('bhvk,bhk->bhv', S, kk_t)[..., None] * b_t[:, :, None, :]
                 + v_t[..., None] * k_t[:, :, None, :])
        if not emit:
            return S_new, None
        y = jnp.einsum('bhvk,bhk->bhv', S if reverse else S_new, r_t)
        return S_new, y
    xs = tuple(jnp.swapaxes(t, 0, 1) for t in (r, w, k, v, kk, b))
    S_fin, ys = lax.scan(step, state0, xs, reverse=reverse)
    return (jnp.swapaxes(ys, 0, 1) if emit else None), S_fin


def rwkv7_output(y, r, k, v, gl, g2, r_k, lnx_g, lnx_b):
    b, l = y.shape[:2]
    yn = head_group_norm(y, lnx_g, lnx_b, RWKV_GN_EPS)
    bonus = (jnp.sum(r * k * r_k, axis=-1, keepdims=True) * v).reshape(b, l, RWKV_WIDTH)
    g = jax.nn.sigmoid(gl) @ g2
    return (yn + bonus) * g


def ab_mixer(hx, hc, w_in, mu_prev, mu_next, w0, w2, a0, a2, g2, k_k, k_a, r_k, lnx_g, lnx_b, ctx_out):
    px = hx @ w_in
    pc = hc @ (w_in if ctx_out else w_in[:, FNET_WIDTH:])
    rx, vx, kkx, dirs_x, glx = rwkv7_features(px[..., FNET_WIDTH:], mu_prev, mu_next, w0, w2, a0, a2, k_k, k_a)
    rc, vc, kkc, dirs_c, glc = rwkv7_features(pc[..., -RWKV_SHIFT_WIDTH:], mu_prev, mu_next, w0, w2, a0, a2, k_k, k_a)
    state0 = jnp.zeros((hx.shape[0], RWKV_HEADS, RWKV_HEAD_DIM, RWKV_HEAD_DIM), jnp.float32)
    ys_x, ys_c = [], []
    for d, reverse in enumerate((False, True)):
        dec_c, k_c, b_c = dirs_c[d]
        y_cd, S_ctx = rwkv7_scan(rc, dec_c, k_c, vc, kkc, b_c, state0, reverse, ctx_out)
        dec_x, k_x, b_x = dirs_x[d]
        y_xd, _ = rwkv7_scan(rx, dec_x, k_x, vx, kkx, b_x, S_ctx, reverse, True)
        ys_x.append(y_xd)
        ys_c.append(y_cd)
    out_x = jnp.concatenate([fourier_mix(px[..., :FNET_WIDTH]),
                             rwkv7_output(ys_x[0] + ys_x[1], rx, dirs_x[0][1], vx, glx, g2, r_k, lnx_g, lnx_b)], axis=-1)
    out_c = None
    if ctx_out:
        out_c = jnp.concatenate([fourier_mix(pc[..., :FNET_WIDTH]),
                                 rwkv7_output(ys_c[0] + ys_c[1], rc, dirs_c[0][1], vc, glc, g2, r_k, lnx_g, lnx_b)], axis=-1).astype(hc.dtype)
    return out_x.astype(hx.dtype), out_c


def retention_chunks(q, k, v, log_gamma, state0, exclusive, emit):
    b, l, h, _ = k.shape
    n = l // RET_CHUNK

    def chunks(t):
        return jnp.moveaxis(t.reshape(b, n, RET_CHUNK, h, t.shape[-1]), (1, 3), (0, 2))

    idx = jnp.arange(RET_CHUNK, dtype=jnp.float32)
    diff = idx[:, None] - idx[None, :]
    mask = diff > 0 if exclusive else diff >= 0
    inner_decay = jnp.where(mask, jnp.exp(log_gamma[:, None, None] * jnp.maximum(diff, 0.0)), 0.0)
    q_decay = jnp.exp(log_gamma[:, None] * (idx + 1.0))
    k_decay = jnp.exp(log_gamma[:, None] * (RET_CHUNK - 1.0 - idx))
    chunk_decay = jnp.exp(log_gamma * RET_CHUNK)

    def update(R, kb, vb):
        return R * chunk_decay[None, :, None, None] + jnp.einsum('bhjd,bhje->bhde', kb * k_decay[None, :, :, None], vb)

    if emit:
        def step(R, inp):
            qb, kb, vb = inp
            s = jnp.einsum('bhid,bhjd->bhij', qb, kb) * inner_decay[None]
            o = (jnp.einsum('bhij,bhje->bhie', s, vb)
                 + jnp.einsum('bhid,bhde->bhie', qb, R) * q_decay[None, :, :, None])
            return update(R, kb, vb), o
        R_fin, ys = lax.scan(step, state0, (chunks(q), chunks(k), chunks(v)))
        y = jnp.moveaxis(ys, (0, 2), (1, 3)).reshape(b, l, h, v.shape[-1])
        return y, R_fin

    def step_state(R, inp):
        kb, vb = inp
        return update(R, kb, vb), None
    R_fin, _ = lax.scan(step_state, state0, (chunks(k), chunks(v)))
    return None, R_fin


def retention_output(y, g, gn_g, gn_b):
    return head_group_norm(y, gn_g, gn_b, RET_GN_EPS) * jax.nn.silu(g.astype(jnp.float32))


def conformer_conv(u, conv_w, conv_b, ln_g, ln_b):
    u = u.astype(jnp.float32)
    a, gate = jnp.split(u, 2, axis=-1)
    h = a * jax.nn.sigmoid(gate)
    h = lax.conv_general_dilated(h, conv_w.astype(jnp.float32)[:, None, :], window_strides=(1,),
                                 padding=[(CONV_WIDTH // 2, CONV_WIDTH // 2)],
                                 dimension_numbers=('NWC', 'WIO', 'NWC'),
                                 feature_group_count=CONV_CH) + conv_b
    return jax.nn.silu(layer_norm(h, ln_g, ln_b))


def cd_mixer(hx, hc, rope_cos, rope_sin, w_in, decay_p, gn_g, gn_b, conv_w, conv_b, ln_g, ln_b, ctx_out):
    log_gamma = -jnp.exp(decay_p.astype(jnp.float32))
    widths = [RET_QK_WIDTH, RET_QK_WIDTH, RET_V_WIDTH, RET_V_WIDTH, 2 * CONV_CH]
    k_scale = RET_QK_DIM ** -0.5

    def heads(t, dim):
        return t.reshape(t.shape[:-1] + (-1, dim)).astype(jnp.float32)

    qx, kx, vx, gx, ux = split_cols(hx @ w_in, widths)
    qx = apply_rope(heads(qx, RET_QK_DIM), rope_cos, rope_sin)
    kx = apply_rope(heads(kx, RET_QK_DIM), rope_cos, rope_sin) * k_scale
    vx = heads(vx, RET_V_DIM)
    if ctx_out:
        qc, kc, vc, gc, uc = split_cols(hc @ w_in, widths)
        qc = heads(qc, RET_QK_DIM)
    else:
        kc, vc = split_cols(hc @ w_in[:, RET_QK_WIDTH:2 * RET_QK_WIDTH + RET_V_WIDTH], widths[1:3])
        qc = None
    kc = heads(kc, RET_QK_DIM) * k_scale
    vc = heads(vc, RET_V_DIM)

    def flip(t):
        return None if t is None else jnp.flip(t, axis=1)

    state0 = jnp.zeros((hx.shape[0], RET_HEADS, RET_QK_DIM, RET_V_DIM), jnp.float32)
    yc_f, R_f = retention_chunks(qc, kc, vc, log_gamma[0], state0, False, ctx_out)
    yx_f, _ = retention_chunks(qx, kx, vx, log_gamma[0], R_f, False, True)
    yc_b, R_b = retention_chunks(flip(qc), flip(kc), flip(vc), log_gamma[1], state0, True, ctx_out)
    yx_b, _ = retention_chunks(flip(qx), flip(kx), flip(vx), log_gamma[1], R_b, True, True)

    out_x = jnp.concatenate([retention_output(yx_f + flip(yx_b), gx, gn_g, gn_b),
                             conformer_conv(ux, conv_w, conv_b, ln_g, ln_b)], axis=-1)
    out_c = None
    if ctx_out:
        out_c = jnp.concatenate([retention_output(yc_f + flip(yc_b), gc, gn_g, gn_b),
                                 conformer_conv(uc, conv_w, conv_b, ln_g, ln_b)], axis=-1).astype(hc.dtype)
    return out_x.astype(hx.dtype), out_c


def setup_inputs(seed: int = 0) -> dict:
    key = jax.random.key(seed)
    ks = iter(jax.random.split(key, 48))

    def nrm(shape, scale):
        return scale * jax.random.normal(next(ks), shape, jnp.float32)

    def gain(shape):
        return 1.0 + nrm(shape, 0.02)

    def unif(shape, lo, hi):
        return jax.random.uniform(next(ks), shape, jnp.float32, lo, hi)

    D = D_MODEL
    W = RWKV_WIDTH
    gam = 1.0 - 2.0 ** (-5.0 - np.arange(RET_HEADS))
    p0 = jnp.asarray(np.log(-np.log(gam)).astype(np.float32))
    return {
        'x': nrm((BATCH, SEQ, D), 1.0),
        'c': nrm((BATCH, D), 1.0),
        'ctx': nrm((BATCH, CTX_LEN, D), 1.0),
        'c_ctx': nrm((D,), 1.0),
        'ada_w': nrm((DEPTH, D, 6 * D), 0.5 * D ** -0.5),
        'ada_b': nrm((DEPTH, 6 * D), 0.01),
        'norm_mix_g': gain((DEPTH, D)),
        'norm_ffn_g': gain((DEPTH, D)),
        'ab_w_in': nrm((N_AB, D, AB_IN), D ** -0.5),
        'ab_mu_prev': unif((N_AB, RWKV_SHIFT_WIDTH), 0.0, 0.5),
        'ab_mu_next': unif((N_AB, RWKV_SHIFT_WIDTH), 0.0, 0.5),
        'ab_w0': unif((N_AB, 2, W), -4.0, 0.0),
        'ab_w2': nrm((N_AB, 2, RWKV_DECAY_RANK, W), 0.1 * RWKV_DECAY_RANK ** -0.5),
        'ab_a0': nrm((N_AB, 2, W), 0.1),
        'ab_a2': nrm((N_AB, 2, RWKV_AIC_RANK, W), 0.1 * RWKV_AIC_RANK ** -0.5),
        'ab_g2': nrm((N_AB, RWKV_GATE_RANK, W), RWKV_GATE_RANK ** -0.5),
        'ab_k_k': 0.85 + nrm((N_AB, W), 0.02),
        'ab_k_a': gain((N_AB, W)),
        'ab_r_k': nrm((N_AB, RWKV_HEADS, RWKV_HEAD_DIM), 0.1),
        'ab_lnx_g': gain((N_AB, W)),
        'ab_lnx_b': nrm((N_AB, W), 0.01),
        'ab_w_out': nrm((N_AB, D, D), D ** -0.5),
        'cd_w_in': nrm((N_CD, D, CD_IN), D ** -0.5),
        'cd_decay_p': p0 + nrm((N_CD, 2, RET_HEADS), 0.05),
        'cd_gn_g': gain((N_CD, RET_V_WIDTH)),
        'cd_gn_b': nrm((N_CD, RET_V_WIDTH), 0.01),
        'cd_conv_w': nrm((N_CD, CONV_WIDTH, CONV_CH), CONV_WIDTH ** -0.5),
        'cd_conv_b': nrm((N_CD, CONV_CH), 0.01),
        'cd_ln_g': gain((N_CD, CONV_CH)),
        'cd_ln_b': nrm((N_CD, CONV_CH), 0.01),
        'cd_w_out': nrm((N_CD, D, D), D ** -0.5),
        'ffn_w1': nrm((DEPTH, D, D_FF), D ** -0.5),
        'ffn_w3': nrm((DEPTH, D, D_FF), D ** -0.5),
        'ffn_w2': nrm((DEPTH, D_FF, D), D_FF ** -0.5),
        'final_g': gain((D,)),
    }


def reference(x, c, ctx, c_ctx, ada_w, ada_b, norm_mix_g, norm_ffn_g,
              ab_w_in, ab_mu_prev, ab_mu_next, ab_w0, ab_w2, ab_a0, ab_a2, ab_g2, ab_k_k, ab_k_a, ab_r_k,
              ab_lnx_g, ab_lnx_b, ab_w_out,
              cd_w_in, cd_decay_p, cd_gn_g, cd_gn_b, cd_conv_w, cd_conv_b, cd_ln_g, cd_ln_b, cd_w_out,
              ffn_w1, ffn_w3, ffn_w2, final_g):
    rope_cos, rope_sin = axial_rope(x.shape[1], RET_QK_DIM)
    lat, con = x, ctx
    for i in range(DEPTH):
        last = i == DEPTH - 1
        j = i // 2
        mod_x = [m[:, None, :] for m in jnp.split(jax.nn.silu(c) @ ada_w[i] + ada_b[i], 6, axis=-1)]
        mod_c = jnp.split(jax.nn.silu(c_ctx) @ ada_w[i] + ada_b[i], 6, axis=-1)
        hx = modulate(rms_norm(lat, norm_mix_g[i]), mod_x[0], mod_x[1])
        hc = modulate(rms_norm(con, norm_mix_g[i]), mod_c[0], mod_c[1])
        if i % 2 == 0:
            mx, mc = ab_mixer(hx, hc, ab_w_in[j], ab_mu_prev[j], ab_mu_next[j], ab_w0[j], ab_w2[j], ab_a0[j], ab_a2[j],
                              ab_g2[j], ab_k_k[j], ab_k_a[j], ab_r_k[j], ab_lnx_g[j], ab_lnx_b[j], not last)
            w_out = ab_w_out[j]
        else:
            mx, mc = cd_mixer(hx, hc, rope_cos, rope_sin, cd_w_in[j], cd_decay_p[j], cd_gn_g[j], cd_gn_b[j],
                              cd_conv_w[j], cd_conv_b[j], cd_ln_g[j], cd_ln_b[j], not last)
            w_out = cd_w_out[j]
        lat = lat + mod_x[2] * (mx @ w_out)
        lat = lat + mod_x[5] * swiglu(modulate(rms_norm(lat, norm_ffn_g[i]), mod_x[3], mod_x[4]),
                                      ffn_w1[i], ffn_w3[i], ffn_w2[i])
        if not last:
            con = con + mod_c[2] * (mc @ w_out)
            con = con + mod_c[5] * swiglu(modulate(rms_norm(con, norm_ffn_g[i]), mod_c[3], mod_c[4]),
                                          ffn_w1[i], ffn_w3[i], ffn_w2[i])
    return rms_norm(lat, final_g)
```

```cpp
#include <hip/hip_runtime.h>
#include <hip/hip_cooperative_groups.h>
#include <cstdio>
#include <cstdint>
namespace cg = cooperative_groups;
namespace pg8 {
#define PG8_LAS __attribute__((address_space(3)))
typedef unsigned short bf16_t;
typedef short bf16x8 __attribute__((ext_vector_type(8)));
typedef float f32x4 __attribute__((ext_vector_type(4)));
typedef unsigned u32x4 __attribute__((ext_vector_type(4)));
constexpr int BM = 256, BK = 64, HALF = 128, HTB = HALF * BK * 2  , STAGE_BYTES = 8 * HTB, NXCD = 8, WGM = 8;

__host__ __device__ __forceinline__ int lds_byte(int r, int c) { const int st = (r >> 4) * 2 + (c >> 5), rr = r & 15, cc = c & 31, ob = rr * 64 + cc * 2; return st * 1024 + (ob ^ (((ob >> 9) & 1) << 5)); }
__host__ __device__ __forceinline__ void stage_rc(int b, int& R, int& C) { const int st = b / 1024, sb = b % 1024, swz = sb ^ (((sb >> 9) & 1) << 5); R = (st >> 1) * 16 + swz / 64; C = (st & 1) * 32 + (swz % 64) / 2; }
__host__ __device__ __forceinline__ int perm32(int rho) { const int n = rho >> 4, i = rho & 15; return 8 * (i >> 2) + 4 * n + (i & 3); }

struct Unit { int pm, pn; };
struct Gemm { const bf16_t* A; const bf16_t* Bt; int M, N, K; };

struct StaticOrder {
    int nM, nN, nwg, G, c;
    __host__ __device__ void init(int M, int N, int G_, int c_) { nM = M / BM; nN = N / BM; nwg = nM * nN; G = G_; c = c_; }
    __host__ __device__ bool next(int i, Unit& u) const {
        const long L = (long)i * G + c; if (L >= nwg) return false;
        int wgid = (int)L; { const int q = nwg / NXCD, r = nwg % NXCD, xcd = wgid % NXCD, off = wgid / NXCD; wgid = (xcd < r ? xcd * (q + 1) : r * (q + 1) + (xcd - r) * q) + off; }
        const int nig = WGM * nN, gid = wgid / nig, fm = gid * WGM, gsz = (nM - fm) < WGM ? (nM - fm) : WGM;
        u.pm = fm + ((wgid % nig) % gsz); u.pn = (wgid % nig) / gsz; return true;
    }
    __device__ __forceinline__ void a_ready(const Unit&) const {}
    __device__ __forceinline__ void done(const Unit&) const {}
};
__device__ __forceinline__ unsigned cvt_pk_bf16(float lo, float hi) { unsigned r; asm volatile("v_cvt_pk_bf16_f32 %0, %1, %2" : "=v"(r) : "v"(lo), "v"(hi)); return r; }
typedef float f32x2 __attribute__((ext_vector_type(2)));
template <class Epi, class Sched>
__device__ __forceinline__ void gemm_phase(PG8_LAS unsigned char* lds, const Gemm g, const Sched& S, const Epi& E) {
    int tid_ = threadIdx.x; asm volatile("" : "+v"(tid_));
    const int tid = tid_, wid = __builtin_amdgcn_readfirstlane(tid >> 6), lane = tid & 63, wr = wid >> 2, wc = wid & 3, fr = lane & 15, fq = lane >> 4;
    const int K = g.K, nt = K / BK;
    unsigned voffA[2], voffB[2];
#pragma unroll
    for (int i = 0; i < 2; ++i) { int R, C; stage_rc(tid * 16 + i * 8192, R, C); const int Rb = Epi::PERM ? ((R & ~31) + perm32(R & 31)) : R;
        voffA[i] = (unsigned)(R * K + C) * 2u; voffB[i] = (unsigned)(Rb * K + C) * 2u; }
    const size_t kstep = (size_t)(BK * 2);
    const size_t hstep = (size_t)HALF * K * 2;
    const size_t tstep = 2 * hstep;
    const unsigned ldsw = (unsigned)wid * 1024u;
    const int aoff = lds_byte(wr * 64 + fr, fq * 8), boff = lds_byte(wc * 32 + fr, fq * 8);
#define PG8_SA(b, h) (((b) * 2 + (h)) * HTB)
#define PG8_SB(b, h) ((4 + (b) * 2 + (h)) * HTB)
#define PG8_STAGE(bufoff, gbase, voff) do { _Pragma("unroll") for (int _i = 0; _i < 2; ++_i) \
        __builtin_amdgcn_global_load_lds((const unsigned*)((const char*)(gbase) + (voff)[_i]), (PG8_LAS unsigned*)(lds + (bufoff) + ldsw + _i * 8192), 16, 0, 0); } while (0)
#define PG8_LDA(dst, b, h) do { _Pragma("unroll") for (int m = 0; m < 4; ++m) _Pragma("unroll") for (int k = 0; k < 2; ++k) dst[m][k] = *(const PG8_LAS bf16x8*)(lds + PG8_SA(b, h) + aoff + m * 2048 + k * 1024); } while (0)
#define PG8_LDB(dst, b, h) do { _Pragma("unroll") for (int n = 0; n < 2; ++n) _Pragma("unroll") for (int k = 0; k < 2; ++k) dst[n][k] = *(const PG8_LAS bf16x8*)(lds + PG8_SB(b, h) + boff + n * 2048 + k * 1024); } while (0)
#define PG8_MMA(ai, bj, At, Bt) do { __builtin_amdgcn_s_setprio(1); _Pragma("unroll") for (int m = 0; m < 4; ++m) _Pragma("unroll") for (int n = 0; n < 2; ++n) _Pragma("unroll") for (int k = 0; k < 2; ++k) \
        acc[ai][bj][m][n] = __builtin_amdgcn_mfma_f32_16x16x32_bf16(Bt[n][k], At[m][k], acc[ai][bj][m][n], 0, 0, 0); __builtin_amdgcn_s_setprio(0); } while (0)
#define PG8_WAIT_V(n) asm volatile("s_waitcnt vmcnt(" #n ")" ::: "memory")
#define PG8_WAIT_L(n) asm volatile("s_waitcnt lgkmcnt(" #n ")" ::: "memory")
#define PG8_BAR __builtin_amdgcn_s_barrier()
#define PG8_SCHED __builtin_amdgcn_sched_barrier(0)
    Unit cur, nxt; int ui = 0;
    if (!S.next(0, cur)) return;
    f32x4 acc[2][2][4][2];
#pragma unroll
    for (int a = 0; a < 2; ++a)
#pragma unroll
        for (int b = 0; b < 2; ++b)
#pragma unroll
            for (int m = 0; m < 4; ++m)
#pragma unroll
                for (int n = 0; n < 2; ++n) acc[a][b][m][n] = (f32x4){0.f, 0.f, 0.f, 0.f};
    bf16x8 At[4][2], B0[2][2], B1[2][2];
    const char* cA = (const char*)g.A + (size_t)cur.pm * tstep; const char* cB = (const char*)g.Bt + (size_t)cur.pn * tstep;
    S.a_ready(cur);
    PG8_STAGE(PG8_SB(0, 0), cB, voffB); PG8_STAGE(PG8_SA(0, 0), cA, voffA); PG8_STAGE(PG8_SB(0, 1), cB + hstep, voffB); PG8_STAGE(PG8_SA(0, 1), cA + hstep, voffA);
    if (wr == 1) PG8_BAR;
    PG8_WAIT_V(4); PG8_BAR;
    PG8_STAGE(PG8_SB(1, 0), cB + kstep, voffB); PG8_STAGE(PG8_SA(1, 0), cA + kstep, voffA); PG8_STAGE(PG8_SB(1, 1), cB + hstep + kstep, voffB);
    PG8_WAIT_V(6); PG8_BAR;
    for (;;) {
        const bool has_next = S.next(ui + 1, nxt);
        const char* nA = has_next ? (const char*)g.A + (size_t)nxt.pm * tstep : cA; const char* nB = has_next ? (const char*)g.Bt + (size_t)nxt.pn * tstep : cB;
        for (int t = 0; t < nt; t += 2) {
            const bool last = (t == nt - 2);
            const char* a1 = cA + (size_t)(t + 1) * kstep;
            const char* a2 = last ? nA : cA + (size_t)(t + 2) * kstep; const char* b2 = last ? nB : cB + (size_t)(t + 2) * kstep;
            const char* a3 = a2 + kstep; const char* b3 = b2 + kstep;
            if (last && has_next) S.a_ready(nxt);
            PG8_LDB(B0, 0, 0); PG8_SCHED; PG8_LDA(At, 0, 0); PG8_STAGE(PG8_SA(1, 1), a1 + hstep, voffA);
            PG8_WAIT_L(8); PG8_BAR; PG8_WAIT_L(0); PG8_MMA(0, 0, At, B0); PG8_BAR; PG8_SCHED;
            PG8_LDB(B1, 0, 1); PG8_STAGE(PG8_SB(0, 0), b2, voffB);
            PG8_BAR; PG8_WAIT_L(0); PG8_MMA(0, 1, At, B1); PG8_BAR;
            PG8_LDA(At, 0, 1); PG8_STAGE(PG8_SA(0, 0), a2, voffA);
            PG8_BAR; PG8_WAIT_L(0); PG8_MMA(1, 0, At, B0); PG8_BAR; PG8_SCHED;
            PG8_STAGE(PG8_SB(0, 1), b2 + hstep, voffB);
            PG8_WAIT_V(6); PG8_BAR; PG8_MMA(1, 1, At, B1); PG8_BAR;
            PG8_LDB(B0, 1, 0); PG8_SCHED; PG8_LDA(At, 1, 0); PG8_STAGE(PG8_SA(0, 1), a2 + hstep, voffA);
            PG8_WAIT_L(8); PG8_BAR; PG8_WAIT_L(0); PG8_MMA(0, 0, At, B0); PG8_BAR; PG8_SCHED;
            PG8_LDB(B1, 1, 1); PG8_STAGE(PG8_SB(1, 0), b3, voffB);
            PG8_BAR; PG8_WAIT_L(0); PG8_MMA(0, 1, At, B1); PG8_BAR;
            PG8_LDA(At, 1, 1); PG8_STAGE(PG8_SA(1, 0), a3, voffA);
            PG8_BAR; PG8_WAIT_L(0); PG8_MMA(1, 0, At, B0); PG8_BAR; PG8_SCHED;
            PG8_STAGE(PG8_SB(1, 1), b3 + hstep, voffB);
            PG8_WAIT_V(6); PG8_BAR; PG8_MMA(1, 1, At, B1); PG8_BAR;
        }
        if constexpr (!Epi::AFTER_DRAIN) { E(acc, cur, wr, wc, fr, fq); S.done(cur); }
        if (!has_next) break;
#pragma unroll
        for (int a = 0; a < 2; ++a)
#pragma unroll
            for (int b = 0; b < 2; ++b)
#pragma unroll
                for (int m = 0; m < 4; ++m)
#pragma unroll
                    for (int n = 0; n < 2; ++n) acc[a][b][m][n] = (f32x4){0.f, 0.f, 0.f, 0.f};
        cur = nxt; cA = nA; cB = nB; ++ui;
    }
    PG8_WAIT_V(0);
    if (wr == 0) PG8_BAR;
    PG8_BAR;
    if constexpr (Epi::AFTER_DRAIN) { E.fused(acc, cur, wr, wc, fr, fq, lds, wid, lane); S.done(cur); }
#undef PG8_SA
#undef PG8_SB
#undef PG8_STAGE
#undef PG8_LDA
#undef PG8_LDB
#undef PG8_MMA
#undef PG8_WAIT_V
#undef PG8_WAIT_L
#undef PG8_BAR
#undef PG8_SCHED
}
}
#define LAS __attribute__((address_space(3)))
typedef unsigned short bf16_t;
using pg8::bf16x8; using pg8::f32x4; using pg8::cvt_pk_bf16;
typedef unsigned u32x2 __attribute__((ext_vector_type(2)));
typedef unsigned u32x4 __attribute__((ext_vector_type(4)));

constexpr int D = 1024, NBAT = 16, SEQ = 2048, CTX = 256, XR = NBAT * SEQ, CR = NBAT * CTX, TOK = XR + CR;
constexpr int PW = 2816, FF = 2816, NABIN = 3328, RW = 768;
constexpr int NT = 512;
constexpr int LDS_BYTES = 147456;

constexpr size_t WS_WABIN = 0;
constexpr size_t WS_WABOUT = WS_WABIN + (size_t)NABIN * 1024 * 2;
constexpr size_t WS_WCDIN = WS_WABOUT + (size_t)1024 * 1024 * 2;
constexpr size_t WS_WCDOUT = WS_WCDIN + (size_t)2816 * 1024 * 2;
constexpr size_t WS_W13 = WS_WCDOUT + (size_t)1024 * 1024 * 2;
constexpr size_t WS_W2 = WS_W13 + (size_t)2 * 5632 * 1024 * 2;
constexpr size_t WS_G2 = WS_W2 + (size_t)2 * 1024 * 2816 * 2;
constexpr size_t WS_TX = WS_G2 + (size_t)768 * 256 * 2;
constexpr size_t WS_TC = WS_TX + (size_t)2048 * 4096 * 2;
constexpr size_t WS_ROPE = WS_TC + (size_t)256 * 512 * 2;
constexpr size_t WS_MODX = WS_ROPE + (size_t)2048 * 64 * 4;
constexpr size_t WS_MODC = WS_MODX + (size_t)2 * 16 * 6144 * 4;
constexpr size_t WS_BONUS = WS_MODC + (size_t)2 * 6144 * 4;
constexpr size_t WS_CON = WS_BONUS + (size_t)TOK * 12 * 4;
constexpr size_t WS_HM = WS_CON + (size_t)CR * 1024 * 4;
constexpr size_t WS_P = WS_HM + (size_t)TOK * 1024 * 2;
constexpr size_t WS_SCR = WS_P + (size_t)TOK * PW * 2;
constexpr size_t WS_VTX = WS_SCR;
constexpr size_t WS_VTC = WS_VTX + (size_t)4096 * 4096 * 2;
constexpr size_t WS_GG = WS_VTC + (size_t)4096 * 512 * 2;
constexpr size_t WS_YRF = WS_SCR;
constexpr size_t WS_YRB = WS_SCR + (size_t)XR * 768 * 2;
constexpr size_t WS_END = WS_SCR + (size_t)100663296;
constexpr size_t DO_YF = 0, DO_YB = (size_t)TOK * 768 * 2, DO_SGL = (size_t)2 * TOK * 768 * 2;

struct Params { const float* in[35]; float* out; unsigned char* ws; };
enum { I_X = 0, I_C, I_CTX, I_CCTX, I_ADAW, I_ADAB, I_NMIXG, I_NFFNG, I_ABWIN, I_MUP, I_MUN, I_W0, I_W2, I_A0, I_A2, I_G2, I_KK, I_KA, I_RK, I_LNXG, I_LNXB, I_ABWOUT,
       I_CDWIN, I_DECAYP, I_GNG, I_GNB, I_CONVW, I_CONVB, I_LNG, I_LNB, I_CDWOUT, I_W1, I_W3, I_FW2, I_FINALG };

__device__ __forceinline__ unsigned short f2bf(float f) { unsigned u = __float_as_uint(f); u += 0x7FFFu + ((u >> 16) & 1u); return (unsigned short)(u >> 16); }
__device__ __forceinline__ float bf2f(unsigned short b) { return __uint_as_float(((unsigned)b) << 16); }
__device__ __forceinline__ float bflo(unsigned w) { return __uint_as_float(w << 16); }
__device__ __forceinline__ float bfhi(unsigned w) { return __uint_as_float(w & 0xffff0000u); }
__device__ __forceinline__ unsigned pk2(float lo, float hi) { return (unsigned)f2bf(lo) | ((unsigned)f2bf(hi) << 16); }
__device__ __forceinline__ float wave_sum(float v) {
#pragma unroll
    for (int o = 1; o < 64; o <<= 1) v += __shfl_xor(v, o);
    return v;
}
__device__ __forceinline__ float sigmoidf_(float x) { return 1.0f / (1.0f + __expf(-x)); }
__device__ __forceinline__ float siluf_(float x) { return x / (1.0f + __expf(-x)); }

template <class RM>
__device__ __forceinline__ void tr_item(const float* W, int ldw, int col0, bf16_t* WT, int ldk, int kb, int nb, RM rm, LAS float* scr) {
    const int tid = threadIdx.x;
    { const int n = tid & 63, kq = tid >> 6;
#pragma unroll
      for (int i = 0; i < 8; ++i) { const int k = kq * 8 + i; scr[k * 65 + n] = W[(size_t)(kb * 64 + k) * ldw + col0 + nb * 64 + n]; } }
    __syncthreads();
    { const int nn = tid >> 3, kc = (tid & 7) * 8;
      u32x4 o; o.x = pk2(scr[(kc + 0) * 65 + nn], scr[(kc + 1) * 65 + nn]); o.y = pk2(scr[(kc + 2) * 65 + nn], scr[(kc + 3) * 65 + nn]);
      o.z = pk2(scr[(kc + 4) * 65 + nn], scr[(kc + 5) * 65 + nn]); o.w = pk2(scr[(kc + 6) * 65 + nn], scr[(kc + 7) * 65 + nn]);
      *(u32x4*)(WT + (size_t)rm(nb * 64 + nn) * ldk + kb * 64 + kc) = o; }
    __syncthreads();
}
struct RmOff { int off; __device__ int operator()(int n) const { return n + off; } };
struct RmIl { int s; __device__ int operator()(int n) const { return 32 * (n >> 4) + 16 * s + (n & 15); } };

__device__ __forceinline__ void phase_prep(const Params& p, LAS unsigned char* lds) {
    const int tid = threadIdx.x, bid = blockIdx.x, G = gridDim.x;
    unsigned char* ws = p.ws;
    LAS float* scr = (LAS float*)lds;
    constexpr int T_ABIN = 16 * 42, T_SQ = 256, T_CDIN = 16 * 44, T_FF = 16 * 44, T_W2 = 44 * 16, T_G2 = 2 * 12;
    constexpr int NTR = T_ABIN + T_SQ + T_CDIN + T_SQ + 4 * T_FF + 2 * T_W2 + T_G2;
    for (int it = bid; it < NTR; it += G) {
        int r = it;
        if (r < T_ABIN) { tr_item(p.in[I_ABWIN], 2944, 256, (bf16_t*)(ws + WS_WABIN), 1024, r / 42, r % 42, RmOff{512}, scr); continue; } r -= T_ABIN;
        if (r < T_SQ) { tr_item(p.in[I_ABWOUT], 1024, 0, (bf16_t*)(ws + WS_WABOUT), 1024, r / 16, r % 16, RmOff{0}, scr); continue; } r -= T_SQ;
        if (r < T_CDIN) { tr_item(p.in[I_CDWIN], 2816, 0, (bf16_t*)(ws + WS_WCDIN), 1024, r / 44, r % 44, RmOff{0}, scr); continue; } r -= T_CDIN;
        if (r < T_SQ) { tr_item(p.in[I_CDWOUT], 1024, 0, (bf16_t*)(ws + WS_WCDOUT), 1024, r / 16, r % 16, RmOff{0}, scr); continue; } r -= T_SQ;
        if (r < 4 * T_FF) { const int l = r / (2 * T_FF), s = (r / T_FF) & 1, q = r % T_FF;
            tr_item(p.in[s ? I_W3 : I_W1] + (size_t)l * 1024 * 2816, 2816, 0, (bf16_t*)(ws + WS_W13) + (size_t)l * 5632 * 1024, 1024, q / 44, q % 44, RmIl{s}, scr); continue; } r -= 4 * T_FF;
        if (r < 2 * T_W2) { const int l = r / T_W2, q = r % T_W2;
            tr_item(p.in[I_FW2] + (size_t)l * 2816 * 1024, 1024, 0, (bf16_t*)(ws + WS_W2) + (size_t)l * 1024 * 2816, 2816, q / 16, q % 16, RmOff{0}, scr); continue; } r -= 2 * T_W2;
        tr_item(p.in[I_G2], 768, 0, (bf16_t*)(ws + WS_G2), 256, r / 12, r % 12, RmOff{0}, scr);
    }
    {
        LAS float* ct = scr + 64 * 65;
        for (int it = bid; it < 64; it += G) {
            const int g = it >> 4, kb = it & 15;
            { const int n = tid & 63, kq = tid >> 6;
#pragma unroll
              for (int i = 0; i < 8; ++i) { const int k = kq * 8 + i; scr[k * 65 + n] = p.in[I_ABWIN][(size_t)(kb * 64 + k) * 2944 + g * 64 + n]; } }
            if (tid < 64) { ct[tid] = cosf((float)tid * 0.09817477042468103f); ct[64 + tid] = sinf((float)tid * 0.09817477042468103f); }
            __syncthreads();
            const int k = tid & 63, qg = tid >> 6;
            float ac[8], as[8];
#pragma unroll
            for (int i = 0; i < 8; ++i) { ac[i] = 0.f; as[i] = 0.f; }
            for (int c = 0; c < 64; ++c) { const float w = scr[k * 65 + c];
#pragma unroll
                for (int i = 0; i < 8; ++i) { const int m = ((qg * 8 + i) * c) & 63; ac[i] += w * ct[m]; as[i] += w * ct[64 + m]; } }
            bf16_t* WT = (bf16_t*)(ws + WS_WABIN);
#pragma unroll
            for (int i = 0; i < 8; ++i) { const int q = qg * 8 + i;
                WT[(size_t)(g * 64 + q) * 1024 + kb * 64 + k] = f2bf(ac[i]); WT[(size_t)(256 + g * 64 + q) * 1024 + kb * 64 + k] = f2bf(as[i]); }
            __syncthreads();
        }
    }
    {
        const size_t gt = (size_t)bid * NT + tid, gs = (size_t)G * NT;
        unsigned* TX = (unsigned*)(ws + WS_TX);
        for (size_t i = gt; i < (size_t)2048 * 2048; i += gs) {
            const int pr = (int)(i >> 11), c2 = (int)(i & 2047) * 2; const int sn = c2 >= 2048; const int l = c2 & 2047;
            const float a0 = (float)((pr * l) & 2047) * 0.0030679615757712823f, a1 = (float)((pr * (l + 1)) & 2047) * 0.0030679615757712823f;
            TX[i] = sn ? pk2(-sinf(a0), -sinf(a1)) : pk2(cosf(a0), cosf(a1));
        }
        unsigned* TC = (unsigned*)(ws + WS_TC);
        for (size_t i = gt; i < (size_t)256 * 256; i += gs) {
            const int pr = (int)(i >> 8), c2 = (int)(i & 255) * 2; const int sn = c2 >= 256; const int l = c2 & 255;
            const float a0 = (float)((pr * l) & 255) * 0.02454369260617026f, a1 = (float)((pr * (l + 1)) & 255) * 0.02454369260617026f;
            TC[i] = sn ? pk2(-sinf(a0), -sinf(a1)) : pk2(cosf(a0), cosf(a1));
        }
        float* RP = (float*)(ws + WS_ROPE);
        for (size_t i = gt; i < (size_t)2048 * 32; i += gs) {
            const int t = (int)(i >> 5), pi = (int)(i & 31); const float pos = (pi < 16) ? (float)(t >> 6) : (float)(t & 63);
            const float fr = exp2f(-(float)(pi & 15) * (13.287712379549449f / 16.0f));
            const float ang = pos * fr; RP[t * 64 + pi] = cosf(ang); RP[t * 64 + 32 + pi] = sinf(ang);
        }
        unsigned* Z1 = (unsigned*)(ws + WS_WABIN + (size_t)3200 * 1024 * 2);
        for (size_t i = gt; i < (size_t)128 * 512; i += gs) Z1[i] = 0u;
        unsigned* Z2 = (unsigned*)(ws + WS_G2);
        for (size_t i = gt; i < (size_t)768 * 64; i += gs) { const int r = (int)(i >> 6), c = (int)(i & 63); Z2[r * 128 + 64 + c] = 0u; }
    }
    {
        LAS float* sc = (LAS float*)lds;
        LAS float* part = sc + 17 * 1024;
        bool loaded = false;
        for (int it = bid; it < 192; it += G) {
            if (!loaded) { __syncthreads();
                for (int i = tid; i < 17 * 1024; i += NT) { const float v = (i < 16 * 1024) ? p.in[I_C][i] : p.in[I_CCTX][i - 16 * 1024]; sc[i] = siluf_(v); }
                loaded = true; __syncthreads(); }
            const int l = it / 96, jc = it % 96, j = tid & 63, kq = tid >> 6;
            const float* W = p.in[I_ADAW] + (size_t)l * 1024 * 6144 + jc * 64 + j;
            float acc[17];
#pragma unroll
            for (int r = 0; r < 17; ++r) acc[r] = 0.f;
            for (int k = kq * 128; k < kq * 128 + 128; ++k) { const float w = W[(size_t)k * 6144];
#pragma unroll
                for (int r = 0; r < 17; ++r) acc[r] += sc[r * 1024 + k] * w; }
#pragma unroll
            for (int r = 0; r < 17; ++r) part[(kq * 17 + r) * 64 + j] = acc[r];
            __syncthreads();
            for (int o = tid; o < 17 * 64; o += NT) { const int r = o >> 6, jj = o & 63; float s = p.in[I_ADAB][l * 6144 + jc * 64 + jj];
#pragma unroll
                for (int q = 0; q < 8; ++q) s += part[(q * 17 + r) * 64 + jj];
                if (r < 16) ((float*)(ws + WS_MODX))[((size_t)l * 16 + r) * 6144 + jc * 64 + jj] = s; else ((float*)(ws + WS_MODC))[(size_t)l * 6144 + jc * 64 + jj] = s; }
            __syncthreads();
        }
    }
}

__device__ __forceinline__ void phase_modnorm(const Params& p, const float* latx, const float* latc, const float* g, int layer, int shift_idx, int nrows) {
    const int lane = threadIdx.x & 63, gw = blockIdx.x * 8 + (threadIdx.x >> 6), GW = gridDim.x * 8;
    bf16_t* H = (bf16_t*)(p.ws + WS_HM);
    const float* modx = (const float*)(p.ws + WS_MODX) + (size_t)layer * 16 * 6144; const float* modc = (const float*)(p.ws + WS_MODC) + (size_t)layer * 6144;
    for (int row = gw; row < nrows; row += GW) {
        const float* src = row < XR ? latx + (size_t)row * 1024 : latc + (size_t)(row - XR) * 1024;
        const float* md = row < XR ? modx + (size_t)(row >> 11) * 6144 : modc;
        const float* sh = md + shift_idx * 1024; const float* sc = sh + 1024;
        f32x4 v[4]; float ss = 0.f;
#pragma unroll
        for (int j = 0; j < 4; ++j) { v[j] = *(const f32x4*)(src + j * 256 + lane * 4); ss += v[j].x * v[j].x + v[j].y * v[j].y + v[j].z * v[j].z + v[j].w * v[j].w; }
        const float rstd = rsqrtf(wave_sum(ss) * (1.0f / 1024.0f) + 1e-6f);
#pragma unroll
        for (int j = 0; j < 4; ++j) { const int c = j * 256 + lane * 4; const f32x4 gg = *(const f32x4*)(g + c), s1 = *(const f32x4*)(sc + c), s0 = *(const f32x4*)(sh + c);
            f32x4 o; o.x = v[j].x * rstd * gg.x * (1.f + s1.x) + s0.x; o.y = v[j].y * rstd * gg.y * (1.f + s1.y) + s0.y; o.z = v[j].z * rstd * gg.z * (1.f + s1.z) + s0.z; o.w = v[j].w * rstd * gg.w * (1.f + s1.w) + s0.w;
            u32x2 w; w.x = pk2(o.x, o.y); w.y = pk2(o.z, o.w); *(u32x2*)(H + (size_t)row * 1024 + c) = w; }
    }
}
__device__ __forceinline__ void phase_final_norm(const Params& p) {
    const int lane = threadIdx.x & 63, gw = blockIdx.x * 8 + (threadIdx.x >> 6), GW = gridDim.x * 8;
    const float* g = p.in[I_FINALG];
    for (int row = gw; row < XR; row += GW) {
        float* src = p.out + (size_t)row * 1024;
        f32x4 v[4]; float ss = 0.f;
#pragma unroll
        for (int j = 0; j < 4; ++j) { v[j] = *(const f32x4*)(src + j * 256 + lane * 4); ss += v[j].x * v[j].x + v[j].y * v[j].y + v[j].z * v[j].z + v[j].w * v[j].w; }
        const float rstd = rsqrtf(wave_sum(ss) * (1.0f / 1024.0f) + 1e-6f);
#pragma unroll
        for (int j = 0; j < 4; ++j) { const int c = j * 256 + lane * 4; const f32x4 gg = *(const f32x4*)(g + c);
            f32x4 o; o.x = v[j].x * rstd * gg.x; o.y = v[j].y * rstd * gg.y; o.z = v[j].z * rstd * gg.z; o.w = v[j].w * rstd * gg.w; *(f32x4*)(src + c) = o; }
    }
}
#define EPI_FOR_FRAGS \
    _Pragma("unroll") for (int ai = 0; ai < 2; ++ai) _Pragma("unroll") for (int m = 0; m < 4; ++m) _Pragma("unroll") for (int bj = 0; bj < 2; ++bj) _Pragma("unroll") for (int n = 0; n < 2; ++n)
#define EPI_ROW (u.pm * 256 + ai * 128 + wr * 64 + m * 16 + fr)
#define EPI_COL (u.pn * 256 + bj * 128 + wc * 32 + n * 16 + 4 * fq)
typedef const f32x4 (&AccRef)[2][2][4][2];

struct EpiAbIn {
    static constexpr bool PERM = false, AFTER_DRAIN = false;
    bf16_t* P; bf16_t* VTX; bf16_t* VTC;
    __device__ __forceinline__ void operator()(AccRef acc, const pg8::Unit& u, int wr, int wc, int fr, int fq) const {
        if (u.pn < 2) {
            EPI_FOR_FRAGS { const int row = EPI_ROW, col = EPI_COL; const f32x4 v = acc[ai][bj][m][n];
                const int cs = col >> 8, gq = col & 255;
                bf16_t* dst; size_t st;
                if (row < XR) { const int b = row >> 11, l = row & 2047; dst = VTX + (size_t)(b * 256 + gq) * 4096 + cs * 2048 + l; st = 4096; }
                else { const int r2 = row - XR, b = r2 >> 8, l = r2 & 255; dst = VTC + (size_t)(b * 256 + gq) * 512 + cs * 256 + l; st = 512; }
                dst[0] = f2bf(v.x); dst[st] = f2bf(v.y); dst[2 * st] = f2bf(v.z); dst[3 * st] = f2bf(v.w); }
        } else {
            EPI_FOR_FRAGS { const int row = EPI_ROW, col = EPI_COL - 512; const f32x4 v = acc[ai][bj][m][n];
                u32x2 w; w.x = cvt_pk_bf16(v.x, v.y); w.y = cvt_pk_bf16(v.z, v.w); *(u32x2*)(P + (size_t)row * PW + col) = w; }
        }
    }
};
struct EpiBf16Plain {
    static constexpr bool PERM = false, AFTER_DRAIN = false;
    bf16_t* O; int ldo;
    __device__ __forceinline__ void operator()(AccRef acc, const pg8::Unit& u, int wr, int wc, int fr, int fq) const {
        EPI_FOR_FRAGS { const int row = EPI_ROW, col = EPI_COL; const f32x4 v = acc[ai][bj][m][n];
            u32x2 w; w.x = cvt_pk_bf16(v.x, v.y); w.y = cvt_pk_bf16(v.z, v.w); *(u32x2*)(O + (size_t)row * ldo + col) = w; }
    }
};
struct EpiDft {
    static constexpr bool PERM = false, AFTER_DRAIN = false;
    bf16_t* MX; int rowbase, L; float scale;
    __device__ __forceinline__ void operator()(AccRef acc, const pg8::Unit& u, int wr, int wc, int fr, int fq) const {
        EPI_FOR_FRAGS { const int pr = EPI_ROW, col = EPI_COL; const f32x4 v = acc[ai][bj][m][n]; const int b = col >> 8, gq = col & 255;
            u32x2 w; w.x = cvt_pk_bf16(v.x * scale, v.y * scale); w.y = cvt_pk_bf16(v.z * scale, v.w * scale);
            *(u32x2*)(MX + (size_t)(rowbase + b * L + pr) * 1024 + gq) = w; }
    }
};
struct EpiResid {
    static constexpr bool PERM = false, AFTER_DRAIN = false;
    const float* basex; const float* basec; float* outx; float* outc; const float* gatex  ; const float* gatec;
    __device__ __forceinline__ void operator()(AccRef acc, const pg8::Unit& u, int wr, int wc, int fr, int fq) const {
        EPI_FOR_FRAGS { const int row = EPI_ROW, col = EPI_COL; const f32x4 v = acc[ai][bj][m][n];
            const float* bs; float* o; const float* gt;
            if (row < XR) { bs = basex + (size_t)row * 1024 + col; o = outx + (size_t)row * 1024 + col; gt = gatex + (size_t)(row >> 11) * 6144 + col; }
            else { bs = basec + (size_t)(row - XR) * 1024 + col; o = outc + (size_t)(row - XR) * 1024 + col; gt = gatec + col; }
            const f32x4 b4 = *(const f32x4*)bs, g4 = *(const f32x4*)gt; f32x4 r; r.x = b4.x + g4.x * v.x; r.y = b4.y + g4.y * v.y; r.z = b4.z + g4.z * v.z; r.w = b4.w + g4.w * v.w;
            *(f32x4*)o = r; }
    }
};
struct EpiSwiglu {
    static constexpr bool PERM = false, AFTER_DRAIN = false;
    bf16_t* Gh;
    __device__ __forceinline__ void operator()(AccRef acc, const pg8::Unit& u, int wr, int wc, int fr, int fq) const {
#pragma unroll
        for (int ai = 0; ai < 2; ++ai)
#pragma unroll
            for (int m = 0; m < 4; ++m)
#pragma unroll
                for (int bj = 0; bj < 2; ++bj) { const int row = u.pm * 256 + ai * 128 + wr * 64 + m * 16 + fr, col = u.pn * 128 + bj * 64 + wc * 16 + 4 * fq;
                    const f32x4 a = acc[ai][bj][m][0], b = acc[ai][bj][m][1];
                    u32x2 w; w.x = cvt_pk_bf16(siluf_(a.x) * b.x, siluf_(a.y) * b.y); w.y = cvt_pk_bf16(siluf_(a.z) * b.z, siluf_(a.w) * b.w);
                    *(u32x2*)(Gh + (size_t)row * FF + col) = w; }
    }
};
template <class Epi> __device__ __forceinline__ void run_gemm(LAS unsigned char* lds, const bf16_t* A, const bf16_t* Bt, int M, int N, int K, const Epi& E, int crot = 0) {
    pg8::Gemm g; g.A = A; g.Bt = Bt; g.M = M; g.N = N; g.K = K;
    pg8::StaticOrder S; const int G = gridDim.x; S.init(M, N, G, (int)((blockIdx.x + G - crot) % G));
    pg8::gemm_phase(lds, g, S, E);
    __syncthreads();
}

__device__ __forceinline__ void phase_sgl(const Params& p) {
    const int lane = threadIdx.x & 63, gw = blockIdx.x * 8 + (threadIdx.x >> 6), GW = gridDim.x * 8;
    const bf16_t* P = (const bf16_t*)(p.ws + WS_P); unsigned* SGL = (unsigned*)((unsigned char*)p.out + DO_SGL);
    const int c = 2560 + lane * 2;
    const float mp0 = p.in[I_MUP][c], mp1 = p.in[I_MUP][c + 1], mn0 = p.in[I_MUN][c], mn1 = p.in[I_MUN][c + 1];
    for (int row = gw; row < TOK; row += GW) {
        int t, L; if (row < XR) { t = row & 2047; L = 2048; } else { t = (row - XR) & 255; L = 256; }
        const unsigned w0 = *(const unsigned*)(P + (size_t)row * PW + c);
        const unsigned wm = t > 0 ? *(const unsigned*)(P + (size_t)(row - 1) * PW + c) : 0u;
        const unsigned wp = t < L - 1 ? *(const unsigned*)(P + (size_t)(row + 1) * PW + c) : 0u;
        const float a0 = bflo(w0), a1 = bfhi(w0);
        const float u0 = a0 + mp0 * (bflo(wm) - a0) + mn0 * (bflo(wp) - a0), u1 = a1 + mp1 * (bfhi(wm) - a1) + mn1 * (bfhi(wp) - a1);
        SGL[(size_t)row * 128 + lane] = pk2(sigmoidf_(u0), sigmoidf_(u1));
        SGL[(size_t)row * 128 + 64 + lane] = 0u;
    }
}

template <int CTRL> __device__ __forceinline__ float dppf(float x) { return __builtin_bit_cast(float, __builtin_amdgcn_update_dpp(0, __builtin_bit_cast(int, x), CTRL, 0xF, 0xF, true)); }
__device__ __forceinline__ float red8(float x) { x += dppf<0xB1>(x); x += dppf<0x4E>(x); x += dppf<0x141>(x); return x; }

__device__ __forceinline__ void phase_scan(const Params& p, LAS unsigned char* lds) {
    const int tid = threadIdx.x, lane = tid & 63, wave = tid >> 6, G = gridDim.x;
    const bf16_t* P = (const bf16_t*)(p.ws + WS_P);
    LAS unsigned short* RAW = (LAS unsigned short*)lds;
    LAS float* W2S = (LAS float*)(lds + 21760);
    LAS float* A2S = W2S + 4096;
    LAS float* TWT = A2S + 4096;
    LAS float* ALT = TWT + 64 * 36;
    LAS float* FR = ALT + 64 * 36; LAS float* FW = FR + 2048; LAS float* FKD = FW + 2048; LAS float* FBB = FKD + 2048; LAS float* FKK = FBB + 2048; LAS float* FV = FKK + 2048;
    LAS float* YBUF = FV + 2048;
    for (int unit = blockIdx.x; unit < 384; unit += G) {
        const int dir = unit / 192, rem = unit % 192, b = rem / 12, h = rem % 12;
        bf16_t* Yd = (bf16_t*)((unsigned char*)p.out + (dir ? DO_YB : DO_YF));
        float* BON = (float*)(p.ws + WS_BONUS);
        __syncthreads();
        for (int i = tid; i < 4096; i += NT) { const int r = i >> 6, c = i & 63;
            W2S[i] = p.in[I_W2][((size_t)dir * 64 + r) * 768 + h * 64 + c]; A2S[i] = p.in[I_A2][((size_t)dir * 64 + r) * 768 + h * 64 + c]; }
        const int j = lane, tq = wave;
        float mup[5], mun[5];
#pragma unroll
        for (int s = 0; s < 5; ++s) { const int col = s < 3 ? s * 768 + h * 64 + j : (s == 3 ? 2304 + dir * 64 + j : 2432 + dir * 64 + j); mup[s] = p.in[I_MUP][col]; mun[s] = p.in[I_MUN][col]; }
        const float w0c = p.in[I_W0][dir * 768 + h * 64 + j], a0c = p.in[I_A0][dir * 768 + h * 64 + j];
        const float kkc = p.in[I_KK][h * 64 + j], kac = p.in[I_KA][h * 64 + j], rkc = p.in[I_RK][h * 64 + j];
        const int rl = lane >> 3, kc = lane & 7, vrow = wave * 8 + rl;
        float S[8];
#pragma unroll
        for (int q = 0; q < 8; ++q) S[q] = 0.f;
        u32x4 pre[3];
        auto blk_geom = [&](int blk, int& base, int& L, int& t0) { int lb; if (blk < 8) { base = XR + b * 256; L = 256; lb = blk; } else { base = b * 2048; L = 2048; lb = blk - 8; } t0 = dir ? (L - 32 - lb * 32) : lb * 32; };
        auto prefetch = [&](int blk) { int base, L, t0; blk_geom(blk, base, L, t0);
#pragma unroll
            for (int q = 0; q < 3; ++q) { const int c = tid + 512 * q; pre[q] = (u32x4){0u, 0u, 0u, 0u};
                if (c < 1360) { const int rr = c / 40, cc = c % 40, seg = cc >> 3, off = (cc & 7) * 8; const int t = t0 - 1 + rr;
                    const int col = seg < 3 ? seg * 768 + h * 64 + off : (seg == 3 ? 2304 + dir * 64 + off : 2432 + dir * 64 + off);
                    if (t >= 0 && t < L) pre[q] = *(const u32x4*)(P + (size_t)(base + t) * PW + col); } } };
        prefetch(0);
        for (int blk = 0; blk < 72; ++blk) {
            int base, L, t0; blk_geom(blk, base, L, t0);
#pragma unroll
            for (int q = 0; q < 3; ++q) { const int c = tid + 512 * q; if (c < 1360) *(LAS u32x4*)(RAW + c * 8) = pre[q]; }
            __syncthreads();
            if (blk + 1 < 72) prefetch(blk + 1);
            float kreg[4], rreg[4];
#pragma unroll
            for (int tt = 0; tt < 4; ++tt) { const int t = tq * 4 + tt, rr = t + 1; float u[5];
#pragma unroll
                for (int s = 0; s < 5; ++s) { const float p0 = bf2f(RAW[rr * 320 + s * 64 + j]), pm = bf2f(RAW[(rr - 1) * 320 + s * 64 + j]), pp = bf2f(RAW[(rr + 1) * 320 + s * 64 + j]);
                    u[s] = p0 + mup[s] * (pm - p0) + mun[s] * (pp - p0); }
                rreg[tt] = u[0]; kreg[tt] = u[1]; FR[t * 64 + j] = u[0]; FV[t * 64 + j] = u[2]; TWT[j * 36 + t] = tanhf(u[3]); ALT[j * 36 + t] = u[4]; }
            __syncthreads();
            {
                float aw[4] = {0.f, 0.f, 0.f, 0.f}, aa[4] = {0.f, 0.f, 0.f, 0.f};
#pragma unroll 8
                for (int i = 0; i < 64; ++i) { const float w = W2S[i * 64 + j], a2 = A2S[i * 64 + j]; const f32x4 t4 = *(const LAS f32x4*)(TWT + i * 36 + tq * 4), l4 = *(const LAS f32x4*)(ALT + i * 36 + tq * 4);
                    aw[0] += t4.x * w; aw[1] += t4.y * w; aw[2] += t4.z * w; aw[3] += t4.w * w; aa[0] += l4.x * a2; aa[1] += l4.y * a2; aa[2] += l4.z * a2; aa[3] += l4.w * a2; }
#pragma unroll
                for (int tt = 0; tt < 4; ++tt) { const int t = tq * 4 + tt;
                    const float z = -(w0c + aw[tt]);
                    const float sp = fmaxf(z, 0.f) + log1pf(__expf(-fabsf(z)));
                    const float dec = __expf(-__expf(-sp - 0.5f));
                    const float a = sigmoidf_(a0c + aa[tt]);
                    const float k = kreg[tt], kkv = k * kkc; const float ss = wave_sum(kkv * kkv); const float kk = kkv * rsqrtf(ss + 1e-12f);
                    const float kd = k * (1.f + (a - 1.f) * kac);
                    FW[t * 64 + j] = dec; FKD[t * 64 + j] = kd; FBB[t * 64 + j] = kk * a; FKK[t * 64 + j] = kk;
                    if (dir == 0) { const float bs = wave_sum(rreg[tt] * kd * rkc); if (lane == 0) BON[(size_t)(base + t0 + t) * 12 + h] = bs; } }
            }
            __syncthreads();
            for (int i = 0; i < 32; ++i) { const int t = dir ? 31 - i : i;
                const f32x4 k0 = *(const LAS f32x4*)(FKK + t * 64 + kc * 8), k1 = *(const LAS f32x4*)(FKK + t * 64 + kc * 8 + 4);
                const f32x4 w0 = *(const LAS f32x4*)(FW + t * 64 + kc * 8), w1 = *(const LAS f32x4*)(FW + t * 64 + kc * 8 + 4);
                const f32x4 b0 = *(const LAS f32x4*)(FBB + t * 64 + kc * 8), b1 = *(const LAS f32x4*)(FBB + t * 64 + kc * 8 + 4);
                const f32x4 d0 = *(const LAS f32x4*)(FKD + t * 64 + kc * 8), d1 = *(const LAS f32x4*)(FKD + t * 64 + kc * 8 + 4);
                const f32x4 r0 = *(const LAS f32x4*)(FR + t * 64 + kc * 8), r1 = *(const LAS f32x4*)(FR + t * 64 + kc * 8 + 4);
                const float vv = FV[t * 64 + vrow];
                const float kk8[8] = {k0.x, k0.y, k0.z, k0.w, k1.x, k1.y, k1.z, k1.w}, w8[8] = {w0.x, w0.y, w0.z, w0.w, w1.x, w1.y, w1.z, w1.w};
                const float b8[8] = {b0.x, b0.y, b0.z, b0.w, b1.x, b1.y, b1.z, b1.w}, d8[8] = {d0.x, d0.y, d0.z, d0.w, d1.x, d1.y, d1.z, d1.w};
                const float r8[8] = {r0.x, r0.y, r0.z, r0.w, r1.x, r1.y, r1.z, r1.w};
                float sa = 0.f, yy = 0.f;
#pragma unroll
                for (int q = 0; q < 8; ++q) sa += S[q] * kk8[q];
                if (dir) {
#pragma unroll
                    for (int q = 0; q < 8; ++q) yy += S[q] * r8[q]; }
                sa = red8(sa);
#pragma unroll
                for (int q = 0; q < 8; ++q) S[q] = S[q] * w8[q] + (vv * d8[q] - sa * b8[q]);
                if (!dir) {
#pragma unroll
                    for (int q = 0; q < 8; ++q) yy += S[q] * r8[q]; }
                yy = red8(yy);
                if (kc == 0) YBUF[t * 64 + vrow] = yy;
            }
            __syncthreads();
            { const int t = tid >> 4, j4 = (tid & 15) * 4; const f32x4 y4 = *(const LAS f32x4*)(YBUF + t * 64 + j4);
              u32x2 w; w.x = pk2(y4.x, y4.y); w.y = pk2(y4.z, y4.w); *(u32x2*)(Yd + (size_t)(base + t0 + t) * 768 + h * 64 + j4) = w; }
        }
    }
}

__device__ __forceinline__ void phase_rwkv_out(const Params& p) {
    const int lane = threadIdx.x & 63, gw = blockIdx.x * 8 + (threadIdx.x >> 6), GW = gridDim.x * 8;
    const bf16_t* P = (const bf16_t*)(p.ws + WS_P); const bf16_t* YF = (const bf16_t*)((unsigned char*)p.out + DO_YF); const bf16_t* YB = (const bf16_t*)((unsigned char*)p.out + DO_YB);
    const bf16_t* GG = (const bf16_t*)(p.ws + WS_GG); const float* BON = (const float*)(p.ws + WS_BONUS); bf16_t* MX = (bf16_t*)(p.ws + WS_HM);
    for (int row = gw; row < TOK; row += GW) {
        int t, L; if (row < XR) { t = row & 2047; L = 2048; } else { t = (row - XR) & 255; L = 256; }
#pragma unroll
        for (int ps = 0; ps < 3; ++ps) {
            const int ch = ps * 256 + lane * 4, hh = ch >> 6;
            const u32x2 yf = *(const u32x2*)(YF + (size_t)row * 768 + ch), yb = *(const u32x2*)(YB + (size_t)row * 768 + ch), gg = *(const u32x2*)(GG + (size_t)row * 768 + ch);
            float y[4] = {bflo(yf.x) + bflo(yb.x), bfhi(yf.x) + bfhi(yb.x), bflo(yf.y) + bflo(yb.y), bfhi(yf.y) + bfhi(yb.y)};
            float s = (y[0] + y[1]) + (y[2] + y[3]);
#pragma unroll
            for (int o = 1; o < 16; o <<= 1) s += __shfl_xor(s, o);
            const float mu = s * (1.f / 64.f); float q = 0.f;
#pragma unroll
            for (int e = 0; e < 4; ++e) { y[e] -= mu; q += y[e] * y[e]; }
#pragma unroll
            for (int o = 1; o < 16; o <<= 1) q += __shfl_xor(q, o);
            const float rs = rsqrtf(q * (1.f / 64.f) + 64e-5f);
            const int vc = 1536 + ch;
            const u32x2 v0 = *(const u32x2*)(P + (size_t)row * PW + vc);
            const u32x2 vm = t > 0 ? *(const u32x2*)(P + (size_t)(row - 1) * PW + vc) : (u32x2){0u, 0u};
            const u32x2 vp = t < L - 1 ? *(const u32x2*)(P + (size_t)(row + 1) * PW + vc) : (u32x2){0u, 0u};
            const float p0[4] = {bflo(v0.x), bfhi(v0.x), bflo(v0.y), bfhi(v0.y)}, pm[4] = {bflo(vm.x), bfhi(vm.x), bflo(vm.y), bfhi(vm.y)}, pp[4] = {bflo(vp.x), bfhi(vp.x), bflo(vp.y), bfhi(vp.y)};
            const float g4[4] = {bflo(gg.x), bfhi(gg.x), bflo(gg.y), bfhi(gg.y)};
            const float bon = BON[(size_t)row * 12 + hh];
            float o4[4];
#pragma unroll
            for (int e = 0; e < 4; ++e) { const float uv = p0[e] + p.in[I_MUP][vc + e] * (pm[e] - p0[e]) + p.in[I_MUN][vc + e] * (pp[e] - p0[e]);
                const float yn = y[e] * rs * p.in[I_LNXG][ch + e] + p.in[I_LNXB][ch + e]; o4[e] = (yn + bon * uv) * g4[e]; }
            u32x2 w; w.x = pk2(o4[0], o4[1]); w.y = pk2(o4[2], o4[3]); *(u32x2*)(MX + (size_t)row * 1024 + 256 + ch) = w;
        }
    }
}
template <int NBLK, int KS>
__device__ __forceinline__ void wave_mma(const LAS unsigned short* A, int lda, const LAS unsigned short* B, int ldb, f32x4 (&acc)[NBLK], int fr, int fq) {
#pragma unroll
    for (int ks = 0; ks < KS; ++ks) { const bf16x8 a = *(const LAS bf16x8*)(A + fr * lda + ks * 32 + fq * 8);
#pragma unroll
        for (int nb = 0; nb < NBLK; ++nb) { const bf16x8 b = *(const LAS bf16x8*)(B + (nb * 16 + fr) * ldb + ks * 32 + fq * 8);
            acc[nb] = __builtin_amdgcn_mfma_f32_16x16x32_bf16(b, a, acc[nb], 0, 0, 0); } }
}

__device__ __forceinline__ void retention_unit(const Params& p, LAS unsigned char* lds, int unit) {
    const int tid = threadIdx.x, lane = tid & 63, wave = tid >> 6, fr = lane & 15, fq = lane >> 4;
    const int dir = unit / 96, rem = unit % 96, b = rem / 6, h = rem % 6;
    const bf16_t* P = (const bf16_t*)(p.ws + WS_P); const float* RP = (const float*)(p.ws + WS_ROPE);
    bf16_t* Yd = (bf16_t*)(p.ws + (dir ? WS_YRB : WS_YRF));
    constexpr int LQ = 72, LT = 136;
    LAS unsigned short* Qs = (LAS unsigned short*)lds;
    LAS unsigned short* Ks = Qs + 128 * LQ;
    LAS unsigned short* Ss = Qs;
    LAS unsigned short* KTs = Ks + 128 * LQ;
    LAS unsigned short* VTs = KTs + 64 * LT;
    LAS unsigned short* RTs = VTs + 128 * LT;
    const float lg = -__expf(p.in[I_DECAYP][dir * 6 + h]);
    const float cdec = __expf(lg * 128.f);
    f32x4 racc[4];
#pragma unroll
    for (int nb = 0; nb < 4; ++nb) racc[nb] = (f32x4){0.f, 0.f, 0.f, 0.f};
    __syncthreads();
    for (int i = tid; i < 128 * LQ; i += NT) RTs[i] = 0;
    for (int ch = 0; ch < 18; ++ch) {
        const bool isctx = ch < 2; const int L = isctx ? 256 : 2048, base = isctx ? XR + b * 256 : b * 2048, n = isctx ? ch : ch - 2;
        __syncthreads();
        {
            const int i = tid >> 2, part = tid & 3; const int pos = n * 128 + i; const int t = dir ? (L - 1 - pos) : pos; const size_t ro = (size_t)(base + t) * PW;
            const float kdcy = __expf(lg * (float)(127 - i)) * 0.125f;
            { const u32x4 lo = *(const u32x4*)(P + ro + 384 + h * 64 + part * 8), hi = *(const u32x4*)(P + ro + 384 + h * 64 + 32 + part * 8);
              const unsigned lw[4] = {lo.x, lo.y, lo.z, lo.w}, hw[4] = {hi.x, hi.y, hi.z, hi.w};
#pragma unroll
              for (int e = 0; e < 8; ++e) { const float t1 = (e & 1) ? bfhi(lw[e >> 1]) : bflo(lw[e >> 1]), t2 = (e & 1) ? bfhi(hw[e >> 1]) : bflo(hw[e >> 1]); const int d = part * 8 + e;
                  float c = 1.f, s = 0.f; if (!isctx) { c = RP[t * 64 + d]; s = RP[t * 64 + 32 + d]; }
                  const float o1 = t1 * c - t2 * s, o2 = t1 * s + t2 * c;
                  if (!isctx) { Ks[i * LQ + d] = f2bf(o1 * 0.125f); Ks[i * LQ + d + 32] = f2bf(o2 * 0.125f); }
                  KTs[d * LT + i] = f2bf(o1 * kdcy); KTs[(d + 32) * LT + i] = f2bf(o2 * kdcy); } }
            if (!isctx) { const u32x4 lo = *(const u32x4*)(P + ro + h * 64 + part * 8), hi = *(const u32x4*)(P + ro + h * 64 + 32 + part * 8);
              const unsigned lw[4] = {lo.x, lo.y, lo.z, lo.w}, hw[4] = {hi.x, hi.y, hi.z, hi.w};
#pragma unroll
              for (int e = 0; e < 8; ++e) { const float t1 = (e & 1) ? bfhi(lw[e >> 1]) : bflo(lw[e >> 1]), t2 = (e & 1) ? bfhi(hw[e >> 1]) : bflo(hw[e >> 1]); const int d = part * 8 + e;
                  const float c = RP[t * 64 + d], s = RP[t * 64 + 32 + d];
                  Qs[i * LQ + d] = f2bf(t1 * c - t2 * s); Qs[i * LQ + d + 32] = f2bf(t1 * s + t2 * c); } }
#pragma unroll
            for (int q = 0; q < 4; ++q) { const u32x4 vv = *(const u32x4*)(P + ro + 768 + h * 128 + part * 32 + q * 8); const unsigned vw[4] = {vv.x, vv.y, vv.z, vv.w};
#pragma unroll
                for (int e = 0; e < 8; ++e) VTs[(part * 32 + q * 8 + e) * LT + i] = (unsigned short)((e & 1) ? (vw[e >> 1] >> 16) : (vw[e >> 1] & 0xffffu)); }
        }
        __syncthreads();
        f32x4 oacc[8];
        if (!isctx) {
            f32x4 sacc[8];
#pragma unroll
            for (int nb = 0; nb < 8; ++nb) { sacc[nb] = (f32x4){0.f, 0.f, 0.f, 0.f}; oacc[nb] = (f32x4){0.f, 0.f, 0.f, 0.f}; }
            wave_mma<8, 2>(Qs + wave * 16 * LQ, LQ, Ks, LQ, sacc, fr, fq);
            wave_mma<8, 2>(Qs + wave * 16 * LQ, LQ, RTs, LQ, oacc, fr, fq);
            const int qi = wave * 16 + fr; const float qd = __expf(lg * (float)(qi + 1));
#pragma unroll
            for (int nb = 0; nb < 8; ++nb) { oacc[nb].x *= qd; oacc[nb].y *= qd; oacc[nb].z *= qd; oacc[nb].w *= qd; }
            __syncthreads();
#pragma unroll
            for (int nb = 0; nb < 8; ++nb) { float sv[4] = {sacc[nb].x, sacc[nb].y, sacc[nb].z, sacc[nb].w};
#pragma unroll
                for (int e = 0; e < 4; ++e) { const int jj = nb * 16 + fq * 4 + e; const int df = qi - jj; const bool keep = dir ? (df > 0) : (df >= 0);
                    sv[e] = keep ? sv[e] * __expf(lg * (float)df) : 0.f; }
                u32x2 w; w.x = pk2(sv[0], sv[1]); w.y = pk2(sv[2], sv[3]); *(LAS u32x2*)(Ss + qi * LT + nb * 16 + fq * 4) = w; }
            __syncthreads();
            wave_mma<8, 4>(Ss + wave * 16 * LT, LT, VTs, LT, oacc, fr, fq);
            { const int pos = n * 128 + qi; const int t = dir ? (L - 1 - pos) : pos; bf16_t* dst = Yd + (size_t)(base + t) * 768 + h * 128;
#pragma unroll
              for (int nb = 0; nb < 8; ++nb) { u32x2 w; w.x = pk2(oacc[nb].x, oacc[nb].y); w.y = pk2(oacc[nb].z, oacc[nb].w); *(u32x2*)(dst + nb * 16 + fq * 4) = w; } }
        }
#pragma unroll
        for (int nb = 0; nb < 4; ++nb) { racc[nb].x *= cdec; racc[nb].y *= cdec; racc[nb].z *= cdec; racc[nb].w *= cdec; }
        wave_mma<4, 4>(VTs + wave * 16 * LT, LT, KTs, LT, racc, fr, fq);
        __syncthreads();
#pragma unroll
        for (int nb = 0; nb < 4; ++nb) { u32x2 w; w.x = pk2(racc[nb].x, racc[nb].y); w.y = pk2(racc[nb].z, racc[nb].w); *(LAS u32x2*)(RTs + (wave * 16 + fr) * LQ + nb * 16 + fq * 4) = w; }
    }
}

__device__ __forceinline__ void conv_item(const Params& p, LAS unsigned char* lds, int item) {
    const int tid = threadIdx.x, lane = tid & 63, wave = tid >> 6;
    const int b = item >> 6, t0 = (item & 63) * 32;
    const bf16_t* P = (const bf16_t*)(p.ws + WS_P); bf16_t* MX = (bf16_t*)(p.ws + WS_HM);
    LAS float* Hs = (LAS float*)lds;
    LAS float* Cs = Hs + 62 * 256;
    __syncthreads();
    for (int i = tid; i < 62 * 128; i += NT) { const int rr = i >> 7, c2 = (i & 127) * 2; const int t = t0 - 15 + rr; float h0 = 0.f, h1 = 0.f;
        if (t >= 0 && t < 2048) { const size_t ro = (size_t)(b * 2048 + t) * PW + 2304; const unsigned a = *(const unsigned*)(P + ro + c2), g = *(const unsigned*)(P + ro + 256 + c2);
            h0 = bflo(a) * sigmoidf_(bflo(g)); h1 = bfhi(a) * sigmoidf_(bfhi(g)); }
        Hs[rr * 256 + c2] = h0; Hs[rr * 256 + c2 + 1] = h1; }
    __syncthreads();
    { const int c = tid & 255, th = tid >> 8; float w[31];
#pragma unroll
      for (int j = 0; j < 31; ++j) w[j] = p.in[I_CONVW][j * 256 + c];
      const float cb = p.in[I_CONVB][c];
      for (int tt = 0; tt < 16; ++tt) { const int t = th * 16 + tt; float s = cb;
#pragma unroll
          for (int j = 0; j < 31; ++j) s += Hs[(t + j) * 256 + c] * w[j];
          Cs[t * 256 + c] = s; } }
    __syncthreads();
    for (int tt = 0; tt < 4; ++tt) { const int t = wave * 4 + tt; const f32x4 v = *(const LAS f32x4*)(Cs + t * 256 + lane * 4);
        const float mu = wave_sum((v.x + v.y) + (v.z + v.w)) * (1.f / 256.f);
        const float d0 = v.x - mu, d1 = v.y - mu, d2 = v.z - mu, d3 = v.w - mu;
        const float rs = rsqrtf(wave_sum(d0 * d0 + d1 * d1 + d2 * d2 + d3 * d3) * (1.f / 256.f) + 1e-5f);
        const f32x4 g = *(const f32x4*)(p.in[I_LNG] + lane * 4), bb = *(const f32x4*)(p.in[I_LNB] + lane * 4);
        u32x2 w; w.x = pk2(siluf_(d0 * rs * g.x + bb.x), siluf_(d1 * rs * g.y + bb.y)); w.y = pk2(siluf_(d2 * rs * g.z + bb.z), siluf_(d3 * rs * g.w + bb.w));
        *(u32x2*)(MX + (size_t)(b * 2048 + t0 + t) * 1024 + 768 + lane * 4) = w; }
}
__device__ __forceinline__ void phase_ret_conv(const Params& p, LAS unsigned char* lds) {
    const int bid = blockIdx.x, G = gridDim.x;
    if (G >= 256) {
        if (bid < 192) retention_unit(p, lds, bid);
        else for (int it = bid - 192; it < 1024; it += G - 192) conv_item(p, lds, it);
    } else {
        for (int u = bid; u < 192; u += G) retention_unit(p, lds, u);
        for (int it = bid; it < 1024; it += G) conv_item(p, lds, it);
    }
}
__device__ __forceinline__ void phase_ret_out(const Params& p) {
    const int lane = threadIdx.x & 63, gw = blockIdx.x * 8 + (threadIdx.x >> 6), GW = gridDim.x * 8;
    const bf16_t* P = (const bf16_t*)(p.ws + WS_P); const bf16_t* YF = (const bf16_t*)(p.ws + WS_YRF); const bf16_t* YB = (const bf16_t*)(p.ws + WS_YRB); bf16_t* MX = (bf16_t*)(p.ws + WS_HM);
    for (int row = gw; row < XR; row += GW) {
#pragma unroll
        for (int ps = 0; ps < 3; ++ps) {
            const int ch = ps * 256 + lane * 4;
            const u32x2 yf = *(const u32x2*)(YF + (size_t)row * 768 + ch), yb = *(const u32x2*)(YB + (size_t)row * 768 + ch), gg = *(const u32x2*)(P + (size_t)row * PW + 1536 + ch);
            float y[4] = {bflo(yf.x) + bflo(yb.x), bfhi(yf.x) + bfhi(yb.x), bflo(yf.y) + bflo(yb.y), bfhi(yf.y) + bfhi(yb.y)};
            float s = (y[0] + y[1]) + (y[2] + y[3]);
#pragma unroll
            for (int o = 1; o < 32; o <<= 1) s += __shfl_xor(s, o);
            const float mu = s * (1.f / 128.f); float q = 0.f;
#pragma unroll
            for (int e = 0; e < 4; ++e) { y[e] -= mu; q += y[e] * y[e]; }
#pragma unroll
            for (int o = 1; o < 32; o <<= 1) q += __shfl_xor(q, o);
            const float rs = rsqrtf(q * (1.f / 128.f) + 1e-5f);
            const float g4[4] = {bflo(gg.x), bfhi(gg.x), bflo(gg.y), bfhi(gg.y)}; float o4[4];
#pragma unroll
            for (int e = 0; e < 4; ++e) o4[e] = (y[e] * rs * p.in[I_GNG][ch + e] + p.in[I_GNB][ch + e]) * siluf_(g4[e]);
            u32x2 w; w.x = pk2(o4[0], o4[1]); w.y = pk2(o4[2], o4[3]); *(u32x2*)(MX + (size_t)row * 1024 + ch) = w;
        }
    }
}

__global__ void __launch_bounds__(512) hybrid_fwd(Params p) {
    extern __shared__ __attribute__((aligned(16))) unsigned char shm[];
    LAS unsigned char* lds = (LAS unsigned char*)shm;
    cg::grid_group grid = cg::this_grid();
    unsigned char* ws = p.ws;
    bf16_t* HM = (bf16_t*)(ws + WS_HM); bf16_t* PB = (bf16_t*)(ws + WS_P);
    const float* MODX = (const float*)(ws + WS_MODX); const float* MODC = (const float*)(ws + WS_MODC); float* CON = (float*)(ws + WS_CON);
    phase_prep(p, lds);
    grid.sync();
    phase_modnorm(p, p.in[I_X], p.in[I_CTX], p.in[I_NMIXG], 0, 0, TOK);
    grid.sync();
    { EpiAbIn E; E.P = PB; E.VTX = (bf16_t*)(ws + WS_VTX); E.VTC = (bf16_t*)(ws + WS_VTC);
      run_gemm(lds, HM, (const bf16_t*)(ws + WS_WABIN), TOK, NABIN, 1024, E); }
    grid.sync();
    { EpiDft E; E.MX = HM; E.rowbase = 0; E.L = 2048; E.scale = 0.0027621358640099515f;
      run_gemm(lds, (const bf16_t*)(ws + WS_TX), (const bf16_t*)(ws + WS_VTX), 2048, 4096, 4096, E);
      EpiDft E2; E2.MX = HM; E2.rowbase = XR; E2.L = 256; E2.scale = 0.0078125f;
      run_gemm(lds, (const bf16_t*)(ws + WS_TC), (const bf16_t*)(ws + WS_VTC), 256, 4096, 512, E2, 128);
      phase_sgl(p); }
    grid.sync();
    phase_scan(p, lds);
    { EpiBf16Plain E; E.O = (bf16_t*)(ws + WS_GG); E.ldo = 768;
      run_gemm(lds, (const bf16_t*)((unsigned char*)p.out + DO_SGL), (const bf16_t*)(ws + WS_G2), TOK, 768, 256, E); }
    grid.sync();
    phase_rwkv_out(p);
    grid.sync();
    { EpiResid E; E.basex = p.in[I_X]; E.basec = p.in[I_CTX]; E.outx = p.out; E.outc = CON; E.gatex = MODX + 2 * 1024; E.gatec = MODC + 2 * 1024;
      run_gemm(lds, HM, (const bf16_t*)(ws + WS_WABOUT), TOK, 1024, 1024, E); }
    grid.sync();
    phase_modnorm(p, p.out, CON, p.in[I_NFFNG], 0, 3, TOK);
    grid.sync();
    { EpiSwiglu E; E.Gh = PB; run_gemm(lds, HM, (const bf16_t*)(ws + WS_W13), TOK, 5632, 1024, E); }
    grid.sync();
    { EpiResid E; E.basex = p.out; E.basec = CON; E.outx = p.out; E.outc = CON; E.gatex = MODX + 5 * 1024; E.gatec = MODC + 5 * 1024;
      run_gemm(lds, PB, (const bf16_t*)(ws + WS_W2), TOK, 1024, 2816, E); }
    grid.sync();
    phase_modnorm(p, p.out, CON, p.in[I_NMIXG] + 1024, 1, 0, TOK);
    grid.sync();
    { EpiBf16Plain E; E.O = PB; E.ldo = PW; run_gemm(lds, HM, (const bf16_t*)(ws + WS_WCDIN), TOK, 2816, 1024, E); }
    grid.sync();
    phase_ret_conv(p, lds);
    grid.sync();
    phase_ret_out(p);
    grid.sync();
    { EpiResid E; E.basex = p.out; E.basec = CON; E.outx = p.out; E.outc = CON; E.gatex = MODX + 16 * 6144 + 2 * 1024; E.gatec = MODC + 6144 + 2 * 1024;
      run_gemm(lds, HM, (const bf16_t*)(ws + WS_WCDOUT), XR, 1024, 1024, E); }
    grid.sync();
    phase_modnorm(p, p.out, CON, p.in[I_NFFNG] + 1024, 1, 3, XR);
    grid.sync();
    { EpiSwiglu E; E.Gh = PB; run_gemm(lds, HM, (const bf16_t*)(ws + WS_W13) + (size_t)5632 * 1024, XR, 5632, 1024, E); }
    grid.sync();
    { EpiResid E; E.basex = p.out; E.basec = CON; E.outx = p.out; E.outc = CON; E.gatex = MODX + 16 * 6144 + 5 * 1024; E.gatec = MODC + 6144 + 5 * 1024;
      run_gemm(lds, PB, (const bf16_t*)(ws + WS_W2) + (size_t)1024 * 2816, XR, 1024, 2816, E); }
    grid.sync();
    phase_final_norm(p);
}

extern "C" void kernel_launch(void* const* d_in, const int* in_sizes, int n_in, void* d_out, int out_size, void* d_ws, size_t ws_size, hipStream_t stream) {
    static int grid_blocks = 0;
    if (grid_blocks == 0) {
        if (n_in != 35 || in_sizes[0] != XR * D || out_size != XR * D || ws_size < WS_END) { fprintf(stderr, "kernel_launch: unexpected shapes (n_in %d, in0 %d, out %d, ws %zu need %zu)\n", n_in, n_in > 0 ? in_sizes[0] : -1, out_size, ws_size, (size_t)WS_END); grid_blocks = -1; return; }
        int dev = 0, cus = 0, per_cu = 0;
        hipGetDevice(&dev); hipDeviceGetAttribute(&cus, hipDeviceAttributeMultiprocessorCount, dev);
        if (hipFuncSetAttribute((const void*)hybrid_fwd, hipFuncAttributeMaxDynamicSharedMemorySize, LDS_BYTES) != hipSuccess) { fprintf(stderr, "hipFuncSetAttribute failed\n"); grid_blocks = -1; return; }
        if (hipOccupancyMaxActiveBlocksPerMultiprocessor(&per_cu, (const void*)hybrid_fwd, NT, LDS_BYTES) != hipSuccess || per_cu < 1) { fprintf(stderr, "occupancy query failed (%d)\n", per_cu); (void)hipGetLastError(); per_cu = 1; }
        grid_blocks = cus * per_cu;
        fprintf(stderr, "kernel_launch: grid %d (cus %d x %d)\n", grid_blocks, cus, per_cu);
    }
    if (grid_blocks < 0) return;
    Params p{};
    for (int i = 0; i < 35; ++i) p.in[i] = (const float*)d_in[i];
    p.out = (float*)d_out; p.ws = (unsigned char*)d_ws;
    void* args[] = {&p};
    hipError_t e = hipLaunchCooperativeKernel((const void*)hybrid_fwd, dim3(grid_blocks), dim3(NT), args, LDS_BYTES, stream);
    if (e != hipSuccess) fprintf(stderr, "cooperative launch failed: %s (grid %d)\n", hipGetErrorString(e), grid_blocks);
}
```

```cpp
#include <hip/hip_runtime.h>
#include <hip/hip_cooperative_groups.h>
#include <cstdio>
#include <cstdint>
namespace cg = cooperative_groups;
namespace pg8 {
#define PG8_LAS __attribute__((address_space(3)))
typedef unsigned short bf16_t;
typedef short bf16x8 __attribute__((ext_vector_type(8)));
typedef float f32x4 __attribute__((ext_vector_type(4)));
typedef unsigned u32x4 __attribute__((ext_vector_type(4)));
constexpr int BM = 256, BK = 64, HALF = 128, HTB = HALF * BK * 2  , STAGE_BYTES = 8 * HTB, NXCD = 8, WGM = 8;

__host__ __device__ __forceinline__ int lds_byte(int r, int c) { const int st = (r >> 4) * 2 + (c >> 5), rr = r & 15, cc = c & 31, ob = rr * 64 + cc * 2; return st * 1024 + (ob ^ (((ob >> 9) & 1) << 5)); }
__host__ __device__ __forceinline__ void stage_rc(int b, int& R, int& C) { const int st = b / 1024, sb = b % 1024, swz = sb ^ (((sb >> 9) & 1) << 5); R = (st >> 1) * 16 + swz / 64; C = (st & 1) * 32 + (swz % 64) / 2; }
__host__ __device__ __forceinline__ int perm32(int rho) { const int n = rho >> 4, i = rho & 15; return 8 * (i >> 2) + 4 * n + (i & 3); }

struct Unit { int pm, pn; };
struct Gemm { const bf16_t* A; const bf16_t* Bt; int M, N, K; };

struct StaticOrder {
    int nM, nN, nwg, G, c;
    __host__ __device__ void init(int M, int N, int G_, int c_) { nM = M / BM; nN = N / BM; nwg = nM * nN; G = G_; c = c_; }
    __host__ __device__ bool next(int i, Unit& u) const {
        const long L = (long)i * G + c; if (L >= nwg) return false;
        int wgid = (int)L; { const int q = nwg / NXCD, r = nwg % NXCD, xcd = wgid % NXCD, off = wgid / NXCD; wgid = (xcd < r ? xcd * (q + 1) : r * (q + 1) + (xcd - r) * q) + off; }
        const int nig = WGM * nN, gid = wgid / nig, fm = gid * WGM, gsz = (nM - fm) < WGM ? (nM - fm) : WGM;
        u.pm = fm + ((wgid % nig) % gsz); u.pn = (wgid % nig) / gsz; return true;
    }
    __device__ __forceinline__ void a_ready(const Unit&) const {}
    __device__ __forceinline__ void done(const Unit&) const {}
};
__device__ __forceinline__ unsigned cvt_pk_bf16(float lo, float hi) { unsigned r; asm volatile("v_cvt_pk_bf16_f32 %0, %1, %2" : "=v"(r) : "v"(lo), "v"(hi)); return r; }
typedef float f32x2 __attribute__((ext_vector_type(2)));
template <class Epi, class Sched, bool ALIGN_EPI = false, bool SP2 = false>
__device__ __forceinline__ void gemm_phase(PG8_LAS unsigned char* lds, const Gemm g, const Sched& S, const Epi& E) {
    int tid_ = threadIdx.x; asm volatile("" : "+v"(tid_));
    const int tid = tid_, wid = __builtin_amdgcn_readfirstlane(tid >> 6), lane = tid & 63, wr = wid >> 2, wc = wid & 3, fr = lane & 15, fq = lane >> 4;
    const int K = g.K, nt = K / BK;
    unsigned voffA[2], voffB[2];
#pragma unroll
    for (int i = 0; i < 2; ++i) { int R, C; stage_rc(tid * 16 + i * 8192, R, C); const int Rb = Epi::PERM ? ((R & ~31) + perm32(R & 31)) : R;
        voffA[i] = (unsigned)(R * K + C) * 2u; voffB[i] = (unsigned)(Rb * K + C) * 2u; }
    const size_t kstep = (size_t)(BK * 2);
    const size_t hstep = (size_t)HALF * K * 2;
    const size_t tstep = 2 * hstep;
    const unsigned ldsw = (unsigned)wid * 1024u;
    const int aoff = lds_byte(wr * 64 + fr, fq * 8), boff = lds_byte(wc * 32 + fr, fq * 8);
#define PG8_SA(b, h) (((b) * 2 + (h)) * HTB)
#define PG8_SB(b, h) ((4 + (b) * 2 + (h)) * HTB)
#define PG8_STAGE(bufoff, gbase, voff) do { _Pragma("unroll") for (int _i = 0; _i < 2; ++_i) \
        __builtin_amdgcn_global_load_lds((const unsigned*)((const char*)(gbase) + (voff)[_i]), (PG8_LAS unsigned*)(lds + (bufoff) + ldsw + _i * 8192), 16, 0, 0); } while (0)
#define PG8_LDA(dst, b, h) do { _Pragma("unroll") for (int m = 0; m < 4; ++m) _Pragma("unroll") for (int k = 0; k < 2; ++k) dst[m][k] = *(const PG8_LAS bf16x8*)(lds + PG8_SA(b, h) + aoff + m * 2048 + k * 1024); } while (0)
#define PG8_LDB(dst, b, h) do { _Pragma("unroll") for (int n = 0; n < 2; ++n) _Pragma("unroll") for (int k = 0; k < 2; ++k) dst[n][k] = *(const PG8_LAS bf16x8*)(lds + PG8_SB(b, h) + boff + n * 2048 + k * 1024); } while (0)
#define PG8_MMA(ai, bj, At, Bt) do { __builtin_amdgcn_s_setprio(1); _Pragma("unroll") for (int m = 0; m < 4; ++m) _Pragma("unroll") for (int n = 0; n < 2; ++n) _Pragma("unroll") for (int k = 0; k < 2; ++k) \
        acc[ai][bj][m][n] = __builtin_amdgcn_mfma_f32_16x16x32_bf16(Bt[n][k], At[m][k], acc[ai][bj][m][n], 0, 0, 0); __builtin_amdgcn_s_setprio(0); } while (0)
#define PG8_WAIT_V(n) asm volatile("s_waitcnt vmcnt(" #n ")" ::: "memory")
#define PG8_WAIT_L(n) asm volatile("s_waitcnt lgkmcnt(" #n ")" ::: "memory")
#define PG8_BAR __builtin_amdgcn_s_barrier()
#define PG8_SCHED __builtin_amdgcn_sched_barrier(0)
    Unit cur, nxt; int ui = 0;
    if (!S.next(0, cur)) return;
    f32x4 acc[2][2][4][2];
#pragma unroll
    for (int a = 0; a < 2; ++a)
#pragma unroll
        for (int b = 0; b < 2; ++b)
#pragma unroll
            for (int m = 0; m < 4; ++m)
#pragma unroll
                for (int n = 0; n < 2; ++n) acc[a][b][m][n] = (f32x4){0.f, 0.f, 0.f, 0.f};
    bf16x8 At[4][2], B0[2][2], B1[2][2];
    const char* cA = (const char*)g.A + (size_t)cur.pm * tstep; const char* cB = (const char*)g.Bt + (size_t)cur.pn * tstep;
    S.a_ready(cur);
    if constexpr (SP2) {
        PG8_STAGE(PG8_SB(0, 0), cB, voffB); PG8_STAGE(PG8_SB(0, 1), cB + hstep, voffB); PG8_STAGE(PG8_SA(0, 0), cA, voffA); PG8_STAGE(PG8_SA(0, 1), cA + hstep, voffA);
        if (wr == 1) PG8_BAR;
        PG8_WAIT_V(2); PG8_BAR;
        PG8_STAGE(PG8_SB(1, 0), cB + kstep, voffB); PG8_STAGE(PG8_SA(1, 0), cA + kstep, voffA); PG8_STAGE(PG8_SB(1, 1), cB + hstep + kstep, voffB);
        PG8_WAIT_V(6); PG8_BAR;
    } else {
        PG8_STAGE(PG8_SB(0, 0), cB, voffB); PG8_STAGE(PG8_SA(0, 0), cA, voffA); PG8_STAGE(PG8_SB(0, 1), cB + hstep, voffB); PG8_STAGE(PG8_SA(0, 1), cA + hstep, voffA);
        if (wr == 1) PG8_BAR;
        PG8_WAIT_V(4); PG8_BAR;
        PG8_STAGE(PG8_SB(1, 0), cB + kstep, voffB); PG8_STAGE(PG8_SA(1, 0), cA + kstep, voffA); PG8_STAGE(PG8_SB(1, 1), cB + hstep + kstep, voffB);
        PG8_WAIT_V(6); PG8_BAR;
    }
    for (;;) {
        const bool has_next = S.next(ui + 1, nxt);
        const char* nA = has_next ? (const char*)g.A + (size_t)nxt.pm * tstep : cA; const char* nB = has_next ? (const char*)g.Bt + (size_t)nxt.pn * tstep : cB;
        for (int t = 0; t < nt; t += 2) {
            const bool last = (t == nt - 2);
            const char* a1 = cA + (size_t)(t + 1) * kstep;
            const char* a2 = last ? nA : cA + (size_t)(t + 2) * kstep; const char* b2 = last ? nB : cB + (size_t)(t + 2) * kstep;
            const char* a3 = a2 + kstep; const char* b3 = b2 + kstep;
            if (last && has_next) S.a_ready(nxt);
            if constexpr (SP2) {
            PG8_LDB(B0, 0, 0); PG8_LDB(B1, 0, 1); PG8_SCHED; PG8_LDA(At, 0, 0); PG8_STAGE(PG8_SA(1, 1), a1 + hstep, voffA);
            PG8_WAIT_V(8); PG8_WAIT_L(0); PG8_BAR; PG8_MMA(0, 0, At, B0); PG8_MMA(0, 1, At, B1); PG8_BAR; PG8_SCHED;
            PG8_LDA(At, 0, 1); PG8_STAGE(PG8_SB(0, 0), b2, voffB); PG8_STAGE(PG8_SB(0, 1), b2 + hstep, voffB); PG8_STAGE(PG8_SA(0, 0), a2, voffA);
            PG8_WAIT_V(8); PG8_WAIT_L(0); PG8_BAR; PG8_MMA(1, 0, At, B0); PG8_MMA(1, 1, At, B1); PG8_BAR; PG8_SCHED;
            PG8_LDB(B0, 1, 0); PG8_LDB(B1, 1, 1); PG8_SCHED; PG8_LDA(At, 1, 0); PG8_STAGE(PG8_SA(0, 1), a2 + hstep, voffA);
            PG8_WAIT_V(8); PG8_WAIT_L(0); PG8_BAR; PG8_MMA(0, 0, At, B0); PG8_MMA(0, 1, At, B1); PG8_BAR; PG8_SCHED;
            PG8_LDA(At, 1, 1); PG8_STAGE(PG8_SB(1, 0), b3, voffB); PG8_STAGE(PG8_SB(1, 1), b3 + hstep, voffB); PG8_STAGE(PG8_SA(1, 0), a3, voffA);
            PG8_WAIT_V(8); PG8_WAIT_L(0); PG8_BAR; PG8_MMA(1, 0, At, B0); PG8_MMA(1, 1, At, B1); PG8_BAR; PG8_SCHED;
            } else {
            PG8_LDB(B0, 0, 0); PG8_SCHED; PG8_LDA(At, 0, 0); PG8_STAGE(PG8_SA(1, 1), a1 + hstep, voffA);
            PG8_WAIT_L(8); PG8_BAR; PG8_WAIT_L(0); PG8_MMA(0, 0, At, B0); PG8_BAR; PG8_SCHED;
            PG8_LDB(B1, 0, 1); PG8_STAGE(PG8_SB(0, 0), b2, voffB);
            PG8_BAR; PG8_WAIT_L(0); PG8_MMA(0, 1, At, B1); PG8_BAR;
            PG8_LDA(At, 0, 1); PG8_STAGE(PG8_SA(0, 0), a2, voffA);
            PG8_BAR; PG8_WAIT_L(0); PG8_MMA(1, 0, At, B0); PG8_BAR; PG8_SCHED;
            PG8_STAGE(PG8_SB(0, 1), b2 + hstep, voffB);
            PG8_WAIT_V(6); PG8_BAR; PG8_MMA(1, 1, At, B1); PG8_BAR;
            PG8_LDB(B0, 1, 0); PG8_SCHED; PG8_LDA(At, 1, 0); PG8_STAGE(PG8_SA(0, 1), a2 + hstep, voffA);
            PG8_WAIT_L(8); PG8_BAR; PG8_WAIT_L(0); PG8_MMA(0, 0, At, B0); PG8_BAR; PG8_SCHED;
            PG8_LDB(B1, 1, 1); PG8_STAGE(PG8_SB(1, 0), b3, voffB);
            PG8_BAR; PG8_WAIT_L(0); PG8_MMA(0, 1, At, B1); PG8_BAR;
            PG8_LDA(At, 1, 1); PG8_STAGE(PG8_SA(1, 0), a3, voffA);
            PG8_BAR; PG8_WAIT_L(0); PG8_MMA(1, 0, At, B0); PG8_BAR; PG8_SCHED;
            PG8_STAGE(PG8_SB(1, 1), b3 + hstep, voffB);
            PG8_WAIT_V(6); PG8_BAR; PG8_MMA(1, 1, At, B1); PG8_BAR;
            }
        }
        if constexpr (ALIGN_EPI) { if (wr == 0) PG8_BAR; }
        if constexpr (!Epi::AFTER_DRAIN) { E(acc, cur, wr, wc, fr, fq); S.done(cur); }
        if (!has_next) break;
#pragma unroll
        for (int a = 0; a < 2; ++a)
#pragma unroll
            for (int b = 0; b < 2; ++b)
#pragma unroll
                for (int m = 0; m < 4; ++m)
#pragma unroll
                    for (int n = 0; n < 2; ++n) acc[a][b][m][n] = (f32x4){0.f, 0.f, 0.f, 0.f};
        cur = nxt; cA = nA; cB = nB; ++ui;
        if constexpr (ALIGN_EPI) { if (wr == 1) PG8_BAR; }
    }
    PG8_WAIT_V(0);
    if constexpr (!ALIGN_EPI) { if (wr == 0) PG8_BAR; }
    PG8_BAR;
    if constexpr (Epi::AFTER_DRAIN) { E.fused(acc, cur, wr, wc, fr, fq, lds, wid, lane); S.done(cur); }
#undef PG8_SA
#undef PG8_SB
#undef PG8_STAGE
#undef PG8_LDA
#undef PG8_LDB
#undef PG8_MMA
#undef PG8_WAIT_V
#undef PG8_WAIT_L
#undef PG8_BAR
#undef PG8_SCHED
}
}
#define LAS __attribute__((address_space(3)))
typedef unsigned short bf16_t;
using pg8::bf16x8; using pg8::f32x4;
typedef unsigned u32x2 __attribute__((ext_vector_type(2)));
typedef unsigned u32x4 __attribute__((ext_vector_type(4)));

constexpr int D = 1024, NBAT = 16, SEQ = 2048, CTX = 256, XR = NBAT * SEQ, CR = NBAT * CTX, TOK = XR + CR;
constexpr int PW = 2816, FF = 2816, NABIN = 3328, RW = 768;
constexpr int NT = 512;
constexpr int LDS_BYTES = 147456;

constexpr size_t WS_WABIN = 0;
constexpr size_t WS_WABOUT = WS_WABIN + (size_t)NABIN * 1024 * 2;
constexpr size_t WS_WCDIN = WS_WABOUT + (size_t)1024 * 1024 * 2;
constexpr size_t WS_WCDOUT = WS_WCDIN + (size_t)2816 * 1024 * 2;
constexpr size_t WS_W13 = WS_WCDOUT + (size_t)1024 * 1024 * 2;
constexpr size_t WS_W2 = WS_W13 + (size_t)2 * 5632 * 1024 * 2;
constexpr size_t WS_G2 = WS_W2 + (size_t)2 * 1024 * 2816 * 2;
constexpr size_t WS_TX = WS_G2 + (size_t)768 * 256 * 2;
constexpr size_t WS_TC = WS_TX + (size_t)2048 * 4096 * 2;
constexpr size_t WS_ROPE = WS_TC + (size_t)256 * 512 * 2;
constexpr size_t WS_MODX = WS_ROPE + (size_t)2048 * 64 * 4;
constexpr size_t WS_MODC = WS_MODX + (size_t)2 * 16 * 6144 * 4;
constexpr size_t WS_BONUS = WS_MODC + (size_t)2 * 6144 * 4;
constexpr size_t WS_CON = WS_BONUS + (size_t)TOK * 12 * 4;
constexpr size_t WS_HM = WS_CON + (size_t)CR * 1024 * 4;
constexpr size_t WS_P = WS_HM + (size_t)TOK * 1024 * 2;
constexpr size_t WS_SCR = WS_P + (size_t)TOK * PW * 2;
constexpr size_t WS_VTX = WS_SCR;
constexpr size_t WS_VTC = WS_VTX + (size_t)4096 * 4096 * 2;
constexpr size_t WS_GG = WS_VTC + (size_t)4096 * 512 * 2;
constexpr size_t WS_YRF = WS_SCR;
constexpr size_t WS_YRB = WS_SCR + (size_t)XR * 768 * 2;
constexpr size_t WS_BAR = WS_SCR + (size_t)100663296;
constexpr size_t WS_SS = WS_BAR + 16384;
constexpr size_t WS_SWC = WS_SS + (size_t)2 * TOK * 4;
constexpr size_t WS_END = WS_SWC + (size_t)(5632 + 2816) * 4;
constexpr size_t DO_YF = 0, DO_YB = (size_t)TOK * 768 * 2, DO_SGL = (size_t)2 * TOK * 768 * 2;

__device__ __forceinline__ int tidx() { int t = threadIdx.x; asm volatile("" : "+v"(t)); return t; }
struct Params { const float* in[35]; float* out; unsigned char* ws; };
enum { I_X = 0, I_C, I_CTX, I_CCTX, I_ADAW, I_ADAB, I_NMIXG, I_NFFNG, I_ABWIN, I_MUP, I_MUN, I_W0, I_W2, I_A0, I_A2, I_G2, I_KK, I_KA, I_RK, I_LNXG, I_LNXB, I_ABWOUT,
       I_CDWIN, I_DECAYP, I_GNG, I_GNB, I_CONVW, I_CONVB, I_LNG, I_LNB, I_CDWOUT, I_W1, I_W3, I_FW2, I_FINALG };

typedef __bf16 bf2_t __attribute__((ext_vector_type(2)));
__device__ __forceinline__ unsigned short f2bf(float f) { return __builtin_bit_cast(unsigned short, (__bf16)f); }
__device__ __forceinline__ float bf2f(unsigned short b) { return __uint_as_float(((unsigned)b) << 16); }
__device__ __forceinline__ float bflo(unsigned w) { return __uint_as_float(w << 16); }
__device__ __forceinline__ float bfhi(unsigned w) { return __uint_as_float(w & 0xffff0000u); }
__device__ __forceinline__ unsigned pk2(float lo, float hi) { bf2_t v; v.x = (__bf16)lo; v.y = (__bf16)hi; return __builtin_bit_cast(unsigned, v); }
__device__ __forceinline__ unsigned cvt_pk_bf16(float lo, float hi) { return pk2(lo, hi); }
__device__ __forceinline__ float wave_sum(float v) {
#pragma unroll
    for (int o = 1; o < 64; o <<= 1) v += __shfl_xor(v, o);
    return v;
}
__device__ __forceinline__ float sigmoidf_(float x) { return __builtin_amdgcn_rcpf(1.0f + __expf(-x)); }
__device__ __forceinline__ float siluf_(float x) { return x * __builtin_amdgcn_rcpf(1.0f + __expf(-x)); }

template <class RM>
__device__ __forceinline__ void tr_item(const float* W, int ldw, int col0, bf16_t* WT, int ldk, int kb, int nb, RM rm, LAS float* scr) {
    const int tid = tidx();
    { const int n = tid & 63, kq = tid >> 6;
#pragma unroll
      for (int i = 0; i < 8; ++i) { const int k = kq * 8 + i; scr[k * 65 + n] = W[(size_t)(kb * 64 + k) * ldw + col0 + nb * 64 + n]; } }
    __syncthreads();
    { const int nn = tid >> 3, kc = (tid & 7) * 8;
      u32x4 o; o.x = pk2(scr[(kc + 0) * 65 + nn], scr[(kc + 1) * 65 + nn]); o.y = pk2(scr[(kc + 2) * 65 + nn], scr[(kc + 3) * 65 + nn]);
      o.z = pk2(scr[(kc + 4) * 65 + nn], scr[(kc + 5) * 65 + nn]); o.w = pk2(scr[(kc + 6) * 65 + nn], scr[(kc + 7) * 65 + nn]);
      *(u32x4*)(WT + (size_t)rm(nb * 64 + nn) * ldk + kb * 64 + kc) = o; }
    __syncthreads();
}
struct RmOff { int off; __device__ int operator()(int n) const { return n + off; } };
struct RmIl { int s; __device__ int operator()(int h) const { return 256 * (h >> 7) + 128 * ((h >> 2) & 1) + 32 * ((h >> 5) & 3) + 8 * ((h >> 3) & 3) + 4 * s + (h & 3); } };

constexpr int PREP_T_ABIN = 16 * 42, PREP_NTR = 16 * 42 + 256 + 16 * 44 + 256 + 4 * 16 * 44 + 2 * 44 * 16 + 2 * 12;
__device__ __forceinline__ void prep_transposes(const Params& p, LAS unsigned char* lds, int it0, int it1, int bid, int G) {
    const int tid = tidx();
    unsigned char* ws = p.ws;
    LAS float* scr = (LAS float*)lds;
    constexpr int T_ABIN = 16 * 42, T_SQ = 256, T_CDIN = 16 * 44, T_FF = 16 * 44, T_W2 = 44 * 16, T_G2 = 2 * 12;
    constexpr int NTR = T_ABIN + T_SQ + T_CDIN + T_SQ + 4 * T_FF + 2 * T_W2 + T_G2;
    for (int it = it0 + bid; it < it1; it += G) {
        int r = it;
        if (r < T_ABIN) { tr_item(p.in[I_ABWIN], 2944, 256, (bf16_t*)(ws + WS_WABIN), 1024, r / 42, r % 42, RmOff{512}, scr); continue; } r -= T_ABIN;
        if (r < T_SQ) { tr_item(p.in[I_ABWOUT], 1024, 0, (bf16_t*)(ws + WS_WABOUT), 1024, r / 16, r % 16, RmOff{0}, scr); continue; } r -= T_SQ;
        if (r < T_CDIN) { tr_item(p.in[I_CDWIN], 2816, 0, (bf16_t*)(ws + WS_WCDIN), 1024, r / 44, r % 44, RmOff{0}, scr); continue; } r -= T_CDIN;
        if (r < T_SQ) { tr_item(p.in[I_CDWOUT], 1024, 0, (bf16_t*)(ws + WS_WCDOUT), 1024, r / 16, r % 16, RmOff{0}, scr); continue; } r -= T_SQ;
        if (r < 4 * T_FF) { const int l = r / (2 * T_FF), s = (r / T_FF) & 1, q = r % T_FF;
            tr_item(p.in[s ? I_W3 : I_W1] + (size_t)l * 1024 * 2816, 2816, 0, (bf16_t*)(ws + WS_W13) + (size_t)l * 5632 * 1024, 1024, q / 44, q % 44, RmIl{s}, scr); continue; } r -= 4 * T_FF;
        if (r < 2 * T_W2) { const int l = r / T_W2, q = r % T_W2;
            tr_item(p.in[I_FW2] + (size_t)l * 2816 * 1024, 1024, 0, (bf16_t*)(ws + WS_W2) + (size_t)l * 1024 * 2816, 2816, q / 16, q % 16, RmOff{0}, scr); continue; } r -= 2 * T_W2;
        tr_item(p.in[I_G2], 768, 0, (bf16_t*)(ws + WS_G2), 256, r / 12, r % 12, RmOff{0}, scr);
    }
}
__device__ __forceinline__ void prep_fold_tables(const Params& p, LAS unsigned char* lds, int bid, int G) {
    const int tid = tidx();
    unsigned char* ws = p.ws;
    LAS float* scr = (LAS float*)lds;
    {
        LAS float* ct = scr + 64 * 65;
        for (int it = bid; it < 64; it += G) {
            const int g = it >> 4, kb = it & 15;
            { const int n = tid & 63, kq = tid >> 6;
#pragma unroll
              for (int i = 0; i < 8; ++i) { const int k = kq * 8 + i; scr[k * 65 + n] = p.in[I_ABWIN][(size_t)(kb * 64 + k) * 2944 + g * 64 + n]; } }
            if (tid < 64) { ct[tid] = cosf((float)tid * 0.09817477042468103f); ct[64 + tid] = sinf((float)tid * 0.09817477042468103f); }
            __syncthreads();
            const int k = tid & 63, qg = tid >> 6;
            float ac[8], as[8];
#pragma unroll
            for (int i = 0; i < 8; ++i) { ac[i] = 0.f; as[i] = 0.f; }
            for (int c = 0; c < 64; ++c) { const float w = scr[k * 65 + c];
#pragma unroll
                for (int i = 0; i < 8; ++i) { const int m = ((qg * 8 + i) * c) & 63; ac[i] += w * ct[m]; as[i] += w * ct[64 + m]; } }
            bf16_t* WT = (bf16_t*)(ws + WS_WABIN);
#pragma unroll
            for (int i = 0; i < 8; ++i) { const int q = qg * 8 + i;
                WT[(size_t)(g * 64 + q) * 1024 + kb * 64 + k] = f2bf(ac[i]); WT[(size_t)(256 + g * 64 + q) * 1024 + kb * 64 + k] = f2bf(as[i]); }
            __syncthreads();
        }
    }
    {
        const size_t gt = (size_t)bid * NT + tid, gs = (size_t)G * NT;
        unsigned* TX = (unsigned*)(ws + WS_TX);
        for (size_t i = gt; i < (size_t)2048 * 2048; i += gs) {
            const int pr = (int)(i >> 11), c2 = (int)(i & 2047) * 2; const int sn = c2 >= 2048; const int l = c2 & 2047;
            const float a0 = (float)((pr * l) & 2047) * 0.0030679615757712823f, a1 = (float)((pr * (l + 1)) & 2047) * 0.0030679615757712823f;
            TX[i] = sn ? pk2(-sinf(a0), -sinf(a1)) : pk2(cosf(a0), cosf(a1));
        }
        unsigned* TC = (unsigned*)(ws + WS_TC);
        for (size_t i = gt; i < (size_t)256 * 256; i += gs) {
            const int pr = (int)(i >> 8), c2 = (int)(i & 255) * 2; const int sn = c2 >= 256; const int l = c2 & 255;
            const float a0 = (float)((pr * l) & 255) * 0.02454369260617026f, a1 = (float)((pr * (l + 1)) & 255) * 0.02454369260617026f;
            TC[i] = sn ? pk2(-sinf(a0), -sinf(a1)) : pk2(cosf(a0), cosf(a1));
        }
        float* RP = (float*)(ws + WS_ROPE);
        for (size_t i = gt; i < (size_t)2048 * 32; i += gs) {
            const int t = (int)(i >> 5), pi = (int)(i & 31); const float pos = (pi < 16) ? (float)(t >> 6) : (float)(t & 63);
            const float fr = exp2f(-(float)(pi & 15) * (13.287712379549449f / 16.0f));
            const float ang = pos * fr; RP[t * 64 + pi] = cosf(ang); RP[t * 64 + 32 + pi] = sinf(ang);
        }
        unsigned* Z1 = (unsigned*)(ws + WS_WABIN + (size_t)3200 * 1024 * 2);
        for (size_t i = gt; i < (size_t)128 * 512; i += gs) Z1[i] = 0u;
        unsigned* Z2 = (unsigned*)(ws + WS_G2);
        for (size_t i = gt; i < (size_t)768 * 64; i += gs) { const int r = (int)(i >> 6), c = (int)(i & 63); Z2[r * 128 + 64 + c] = 0u; }
        float* SSZ = (float*)(ws + WS_SS);
        for (size_t i = gt; i < (size_t)2 * TOK; i += gs) SSZ[i] = 0.f;
    }
}
__device__ __forceinline__ void prep_mods(const Params& p, LAS unsigned char* lds, int bid, int G) {
    const int tid = tidx();
    unsigned char* ws = p.ws;
    LAS float* scr = (LAS float*)lds;
    {
        LAS float* sc = (LAS float*)lds;
        LAS float* part = sc + 17 * 1024;
        bool loaded = false;
        for (int it = bid; it < 192; it += G) {
            if (!loaded) { __syncthreads();
                for (int i = tid; i < 17 * 1024; i += NT) { const float v = (i < 16 * 1024) ? p.in[I_C][i] : p.in[I_CCTX][i - 16 * 1024]; sc[i] = siluf_(v); }
                loaded = true; __syncthreads(); }
            const int l = it / 96, jc = it % 96, j = tid & 63, kq = tid >> 6;
            const float* W = p.in[I_ADAW] + (size_t)l * 1024 * 6144 + jc * 64 + j;
            float acc[17];
#pragma unroll
            for (int r = 0; r < 17; ++r) acc[r] = 0.f;
#pragma unroll 1
            for (int k0 = kq * 128; k0 < kq * 128 + 128; k0 += 8) { float w[8];
#pragma unroll
                for (int e = 0; e < 8; ++e) w[e] = W[(size_t)(k0 + e) * 6144];
#pragma unroll
                for (int r = 0; r < 17; ++r) { const f32x4 s4 = *(const LAS f32x4*)(sc + r * 1024 + k0), s5 = *(const LAS f32x4*)(sc + r * 1024 + k0 + 4);
                    acc[r] += (s4.x * w[0] + s4.y * w[1] + s4.z * w[2] + s4.w * w[3]) + (s5.x * w[4] + s5.y * w[5] + s5.z * w[6] + s5.w * w[7]); } }
#pragma unroll
            for (int r = 0; r < 17; ++r) part[(kq * 17 + r) * 64 + j] = acc[r];
            __syncthreads();
            for (int o = tid; o < 17 * 64; o += NT) { const int r = o >> 6, jj = o & 63; float s = p.in[I_ADAB][l * 6144 + jc * 64 + jj];
#pragma unroll
                for (int q = 0; q < 8; ++q) s += part[(q * 17 + r) * 64 + jj];
                if (r < 16) ((float*)(ws + WS_MODX))[((size_t)l * 16 + r) * 6144 + jc * 64 + jj] = s; else ((float*)(ws + WS_MODC))[(size_t)l * 6144 + jc * 64 + jj] = s; }
            __syncthreads();
        }
    }
}
__device__ __forceinline__ void phase_modnorm(const Params& p, const float* latx, const float* latc, const float* g, int layer, int shift_idx, int nrows, int wg = -1, int nwg = 0) {
    if (wg < 0) { wg = blockIdx.x; nwg = gridDim.x; }
    const int lane = tidx() & 63, gw = wg * 8 + (tidx() >> 6), GW = nwg * 8;
    bf16_t* H = (bf16_t*)(p.ws + WS_HM);
    const float* modx = (const float*)(p.ws + WS_MODX) + (size_t)layer * 16 * 6144; const float* modc = (const float*)(p.ws + WS_MODC) + (size_t)layer * 6144;
    for (int row0 = gw * 2; row0 < nrows; row0 += GW * 2) {
        f32x4 v[2][2][2]; float ss[2] = {0.f, 0.f};
#pragma unroll
        for (int r = 0; r < 2; ++r) { const int row = row0 + r; const float* src = row < XR ? latx + (size_t)row * 1024 : latc + (size_t)(row - XR) * 1024;
#pragma unroll
            for (int j = 0; j < 2; ++j) { v[r][j][0] = __builtin_nontemporal_load((const f32x4*)(src + j * 512 + lane * 8)); v[r][j][1] = __builtin_nontemporal_load((const f32x4*)(src + j * 512 + lane * 8 + 4)); } }
#pragma unroll
        for (int r = 0; r < 2; ++r)
#pragma unroll
            for (int j = 0; j < 2; ++j)
#pragma unroll
                for (int h = 0; h < 2; ++h) ss[r] += v[r][j][h].x * v[r][j][h].x + v[r][j][h].y * v[r][j][h].y + v[r][j][h].z * v[r][j][h].z + v[r][j][h].w * v[r][j][h].w;
#pragma unroll
        for (int o = 1; o < 64; o <<= 1) { ss[0] += __shfl_xor(ss[0], o); ss[1] += __shfl_xor(ss[1], o); }
#pragma unroll
        for (int r = 0; r < 2; ++r) { const int row = row0 + r; const float rstd = rsqrtf(ss[r] * (1.0f / 1024.0f) + 1e-6f);
            const float* md = row < XR ? modx + (size_t)(row >> 11) * 6144 : modc; const float* sh = md + shift_idx * 1024; const float* sc = sh + 1024;
#pragma unroll
            for (int j = 0; j < 2; ++j) { const int c = j * 512 + lane * 8; unsigned w[4];
#pragma unroll
                for (int h = 0; h < 2; ++h) { const f32x4 gg = *(const f32x4*)(g + c + 4 * h), s1 = *(const f32x4*)(sc + c + 4 * h), s0 = *(const f32x4*)(sh + c + 4 * h), x = v[r][j][h];
                    w[2 * h] = pk2(x.x * rstd * gg.x * (1.f + s1.x) + s0.x, x.y * rstd * gg.y * (1.f + s1.y) + s0.y); w[2 * h + 1] = pk2(x.z * rstd * gg.z * (1.f + s1.z) + s0.z, x.w * rstd * gg.w * (1.f + s1.w) + s0.w); }
                *(u32x4*)(H + (size_t)row * 1024 + c) = (u32x4){w[0], w[1], w[2], w[3]}; } }
    }
}
__device__ __forceinline__ void phase_final_norm(const Params& p) {
    const int lane = tidx() & 63, gw = blockIdx.x * 8 + (tidx() >> 6), GW = gridDim.x * 8;
    const float* g = p.in[I_FINALG];
    auto loadrows = [&](int row0, f32x4 (&v)[2][4]) {
#pragma unroll
        for (int r = 0; r < 2; ++r) { const float* src = p.out + (size_t)(row0 + r) * 1024;
#pragma unroll
            for (int j = 0; j < 4; ++j) v[r][j] = *(const f32x4*)(src + j * 256 + lane * 4); } };
    auto procrows = [&](int row0, const f32x4 (&v)[2][4]) { float ss[2] = {0.f, 0.f};
#pragma unroll
        for (int r = 0; r < 2; ++r)
#pragma unroll
            for (int j = 0; j < 4; ++j) ss[r] += v[r][j].x * v[r][j].x + v[r][j].y * v[r][j].y + v[r][j].z * v[r][j].z + v[r][j].w * v[r][j].w;
#pragma unroll
        for (int o = 1; o < 64; o <<= 1) { ss[0] += __shfl_xor(ss[0], o); ss[1] += __shfl_xor(ss[1], o); }
#pragma unroll
        for (int r = 0; r < 2; ++r) { float* dst = p.out + (size_t)(row0 + r) * 1024; const float rstd = rsqrtf(ss[r] * (1.0f / 1024.0f) + 1e-6f);
#pragma unroll
            for (int j = 0; j < 4; ++j) { const int c = j * 256 + lane * 4; const f32x4 gg = *(const f32x4*)(g + c), x = v[r][j];
                f32x4 o; o.x = x.x * rstd * gg.x; o.y = x.y * rstd * gg.y; o.z = x.z * rstd * gg.z; o.w = x.w * rstd * gg.w; __builtin_nontemporal_store(o, (f32x4*)(dst + c)); } } };
    const int step = GW * 2; int row0 = gw * 2;
    f32x4 va[2][4], vb[2][4];
    if (row0 < XR) loadrows(row0, va);
    for (; row0 < XR; row0 += 2 * step) {
        const int r1 = row0 + step, r2 = r1 + step; const bool h1 = r1 < XR;
        if (h1) loadrows(r1, vb);
        procrows(row0, va);
        if (r2 < XR) loadrows(r2, va);
        if (h1) procrows(r1, vb);
    }
}

__device__ __forceinline__ void phase_swc(const Params& p) {
    const int lane = tidx() & 63, gw = blockIdx.x * 8 + (tidx() >> 6), GW = gridDim.x * 8;
    const float* MODC = (const float*)(p.ws + WS_MODC); float* SW = (float*)(p.ws + WS_SWC);
    for (int n = gw; n < 5632 + 2816; n += GW) {
        const bool ff = n < 5632; const bf16_t* Wt = ff ? (const bf16_t*)(p.ws + WS_W13) + (size_t)n * 1024 : (const bf16_t*)(p.ws + WS_WCDIN) + (size_t)(n - 5632) * 1024;
        const float* sh = ff ? MODC + 3 * 1024 : MODC + 6144;
        const u32x4 w0 = *(const u32x4*)(Wt + lane * 16), w1 = *(const u32x4*)(Wt + lane * 16 + 8);
        const float wv[16] = {bflo(w0.x), bfhi(w0.x), bflo(w0.y), bfhi(w0.y), bflo(w0.z), bfhi(w0.z), bflo(w0.w), bfhi(w0.w), bflo(w1.x), bfhi(w1.x), bflo(w1.y), bfhi(w1.y), bflo(w1.z), bfhi(w1.z), bflo(w1.w), bfhi(w1.w)};
        float s = 0.f;
#pragma unroll
        for (int q = 0; q < 4; ++q) { const f32x4 x = *(const f32x4*)(sh + lane * 16 + q * 4); s += wv[q * 4] * x.x + wv[q * 4 + 1] * x.y + wv[q * 4 + 2] * x.z + wv[q * 4 + 3] * x.w; }
        s = wave_sum(s); if (lane == 0) SW[n] = s;
    }
}
#define XB_TMO      128
#define XB_XCNT(j)  (256  + 64 * (j))
#define XB_XSUB(j)  (1280 + 64 * (j))
#define XB_XGEN(j)  (2304 + 64 * (j))
#define XB_TOP      3328
#define XB_TOPGEN   3392
#define XCD_BAR_WORDS 3456
#define XB_SPIN_CAP (1u << 18)

__device__ __forceinline__ unsigned xb_ld(unsigned* p)              { return __hip_atomic_load(p, __ATOMIC_RELAXED, __HIP_MEMORY_SCOPE_AGENT); }
__device__ __forceinline__ unsigned xb_add(unsigned* p, unsigned v) { return __hip_atomic_fetch_add(p, v, __ATOMIC_RELAXED, __HIP_MEMORY_SCOPE_AGENT); }
__device__ __forceinline__ unsigned xb_xcc_id() { return (unsigned)__builtin_amdgcn_s_getreg((3 << 11) | 20) & 0xFu; }
#define XB_SPIN(cond, bar) do { unsigned _sp = 0; while (cond) { __builtin_amdgcn_s_sleep(1); \
    if ((++_sp & 255u) == 0u) { if (xb_ld(&(bar)[XB_TMO])) break; if (_sp > XB_SPIN_CAP) { atomicAdd(&(bar)[XB_TMO], 1u); break; } } } } while (0)

struct XcdBarrier {
    unsigned* bar; unsigned x;
    volatile LAS unsigned* st;
};

__device__ __forceinline__ XcdBarrier xcd_barrier_post(unsigned* bar, volatile LAS unsigned* st) {
    XcdBarrier b; b.bar = bar; b.x = xb_xcc_id(); b.st = st;
    if (tidx() == 0) st[2] = xb_add(&bar[XB_XCNT(b.x)], 1u);
    return b;
}
__device__ __forceinline__ void xcd_barrier_complete(unsigned* bar, unsigned x, unsigned& nloc, unsigned& nx) {
    const unsigned G = gridDim.x * gridDim.y * gridDim.z;
    unsigned sum, cnt, mine, sp = 0u;
    for (;;) {
        sum = 0u; cnt = 0u; mine = 0u;
#pragma unroll
        for (unsigned j = 0; j < 16; ++j) { const unsigned c = xb_ld(&bar[XB_XCNT(j)]); sum += c; cnt += (c > 0u) ? 1u : 0u; mine = (j == x) ? c : mine; }
        if (sum == G) break;
        __builtin_amdgcn_s_sleep(1);
        if ((++sp & 255u) == 0u) { if (xb_ld(&bar[XB_TMO])) break; if (sp > XB_SPIN_CAP) { atomicAdd(&bar[XB_TMO], 1u); break; } }
    }
    nloc = mine > 0u ? mine : 1u; nx = cnt > 0u ? cnt : 1u;
}

__device__ __forceinline__ void xcd_barrier(const XcdBarrier& b) {
    asm volatile("s_waitcnt vmcnt(0)" ::: "memory");
    __syncthreads();
    if (tidx() == 0) {
        unsigned* bar = b.bar;
        __builtin_amdgcn_s_waitcnt(0);
        unsigned nloc = b.st[0], nx = b.st[1];
        if (nloc == 0u) { xcd_barrier_complete(bar, b.x, nloc, nx); b.st[0] = nloc; b.st[1] = nx; }
        const unsigned old = xb_add(&bar[XB_XSUB(b.x)], 1u);
        const unsigned gen = old / nloc;
        if (old + 1u == (gen + 1u) * nloc) {
            __builtin_amdgcn_fence(__ATOMIC_RELEASE, "agent");
            asm volatile("s_waitcnt vmcnt(0)" ::: "memory");
            const unsigned og = xb_add(&bar[XB_TOP], 1u);
            const unsigned tg = og / nx;
            if (og + 1u == (tg + 1u) * nx) xb_add(&bar[XB_TOPGEN], 1u);
            else XB_SPIN(xb_ld(&bar[XB_TOPGEN]) == tg, bar);
            __builtin_amdgcn_fence(__ATOMIC_ACQUIRE, "agent");
            xb_add(&bar[XB_XGEN(b.x)], 1u);
            asm volatile("s_waitcnt vmcnt(0)" ::: "memory");
        } else {
            XB_SPIN(xb_ld(&bar[XB_XGEN(b.x)]) == gen, bar);
            __builtin_amdgcn_fence(__ATOMIC_ACQUIRE, "agent");
            asm volatile("s_waitcnt vmcnt(0)" ::: "memory");
        }
    }
    __syncthreads();
}

#ifndef GEMM_ALIGN_EPI
#define GEMM_ALIGN_EPI true
#endif
#ifndef GEMM_SP2
#define GEMM_SP2 true
#endif
#define EPI_FOR_FRAGS \
    _Pragma("unroll") for (int ai = 0; ai < 2; ++ai) _Pragma("unroll") for (int m = 0; m < 4; ++m) _Pragma("unroll") for (int bj = 0; bj < 2; ++bj) _Pragma("unroll") for (int n = 0; n < 2; ++n)
#define EPI_ROW (u.pm * 256 + ai * 128 + wr * 64 + m * 16 + fr)
#define EPI_COL (u.pn * 256 + bj * 128 + wc * 32 + n * 16 + 4 * fq)
typedef const f32x4 (&AccRef)[2][2][4][2];

struct EpiAbIn {
    static constexpr bool PERM = true, AFTER_DRAIN = false;
    bf16_t* P; bf16_t* VTX; bf16_t* VTC;
    __device__ __forceinline__ void operator()(AccRef acc, const pg8::Unit& u, int wr, int wc, int fr, int fq) const {
        if (u.pn < 2) {
            EPI_FOR_FRAGS { const int row = EPI_ROW, col = u.pn * 256 + bj * 128 + wc * 32 + 8 * fq + 4 * n; const f32x4 v = acc[ai][bj][m][n];
                const int cs = col >> 8, gq = col & 255;
                bf16_t* dst; size_t st;
                if (row < XR) { const int b = row >> 11, l = row & 2047; dst = VTX + (size_t)(b * 256 + gq) * 4096 + cs * 2048 + l; st = 4096; }
                else { const int r2 = row - XR, b = r2 >> 8, l = r2 & 255; dst = VTC + (size_t)(b * 256 + gq) * 512 + cs * 256 + l; st = 512; }
                dst[0] = f2bf(v.x); dst[st] = f2bf(v.y); dst[2 * st] = f2bf(v.z); dst[3 * st] = f2bf(v.w); }
        } else {
#pragma unroll
            for (int ai = 0; ai < 2; ++ai)
#pragma unroll
                for (int m = 0; m < 4; ++m)
#pragma unroll
                    for (int bj = 0; bj < 2; ++bj) { const int row = u.pm * 256 + ai * 128 + wr * 64 + m * 16 + fr, col = u.pn * 256 + bj * 128 + wc * 32 + 8 * fq - 512;
                        const f32x4 v0 = acc[ai][bj][m][0], v1 = acc[ai][bj][m][1];
                        u32x4 w; w.x = cvt_pk_bf16(v0.x, v0.y); w.y = cvt_pk_bf16(v0.z, v0.w); w.z = cvt_pk_bf16(v1.x, v1.y); w.w = cvt_pk_bf16(v1.z, v1.w);
                        *(u32x4*)(P + (size_t)row * PW + col) = w; }
        }
    }
};
struct EpiBf16Plain {
    static constexpr bool PERM = true, AFTER_DRAIN = false;
    bf16_t* O; int ldo;
    __device__ __forceinline__ void operator()(AccRef acc, const pg8::Unit& u, int wr, int wc, int fr_, int fq_) const {
        int fr = fr_, fq = fq_; asm volatile("" : "+v"(fr), "+v"(fq));
#pragma unroll
        for (int ai = 0; ai < 2; ++ai)
#pragma unroll
            for (int m = 0; m < 4; ++m)
#pragma unroll
                for (int bj = 0; bj < 2; ++bj) { const int row = u.pm * 256 + ai * 128 + wr * 64 + m * 16 + fr, col = u.pn * 256 + bj * 128 + wc * 32 + 8 * fq;
                    const f32x4 v0 = acc[ai][bj][m][0], v1 = acc[ai][bj][m][1];
                    u32x4 w; w.x = cvt_pk_bf16(v0.x, v0.y); w.y = cvt_pk_bf16(v0.z, v0.w); w.z = cvt_pk_bf16(v1.x, v1.y); w.w = cvt_pk_bf16(v1.z, v1.w);
                    *(u32x4*)(O + (size_t)row * ldo + col) = w; }
    }
};
struct EpiDft {
    static constexpr bool PERM = false, AFTER_DRAIN = false;
    bf16_t* MX; int rowbase, L; float scale;
    __device__ __forceinline__ void operator()(AccRef acc, const pg8::Unit& u, int wr, int wc, int fr, int fq) const {
        EPI_FOR_FRAGS { const int pr = EPI_ROW, col = EPI_COL; const f32x4 v = acc[ai][bj][m][n]; const int b = col >> 8, gq = col & 255;
            u32x2 w; w.x = cvt_pk_bf16(v.x * scale, v.y * scale); w.y = cvt_pk_bf16(v.z * scale, v.w * scale);
            *(u32x2*)(MX + (size_t)(rowbase + b * L + pr) * 1024 + gq) = w; }
    }
};
struct EpiResid {
    static constexpr bool PERM = false, AFTER_DRAIN = false;
    const float* basex; const float* basec; float* outx; float* outc; const float* gatex  ; const float* gatec;
    __device__ __forceinline__ void operator()(AccRef acc, const pg8::Unit& u, int wr, int wc, int fr, int fq) const {
        const int row0 = u.pm * 256; const bool isx = row0 < XR; const float* gt = isx ? gatex + (size_t)(row0 >> 11) * 6144 : gatec;
        const float* bs0 = isx ? basex + (size_t)row0 * 1024 : basec + (size_t)(row0 - XR) * 1024; float* o0 = isx ? outx + (size_t)row0 * 1024 : outc + (size_t)(row0 - XR) * 1024;
        f32x4 g4[2][2];
#pragma unroll
        for (int bj = 0; bj < 2; ++bj)
#pragma unroll
            for (int n = 0; n < 2; ++n) g4[bj][n] = *(const f32x4*)(gt + u.pn * 256 + bj * 128 + wc * 32 + n * 16 + 4 * fq);
        EPI_FOR_FRAGS { const int rl = ai * 128 + wr * 64 + m * 16 + fr, col = EPI_COL; const f32x4 v = acc[ai][bj][m][n], gg = g4[bj][n];
            const f32x4 b4 = *(const f32x4*)(bs0 + (size_t)rl * 1024 + col); f32x4 r; r.x = b4.x + gg.x * v.x; r.y = b4.y + gg.y * v.y; r.z = b4.z + gg.z * v.z; r.w = b4.w + gg.w * v.w;
            *(f32x4*)(o0 + (size_t)rl * 1024 + col) = r; }
    }
};
struct EpiSwiglu {
    static constexpr bool PERM = true, AFTER_DRAIN = false;
    bf16_t* Gh;
    __device__ __forceinline__ void operator()(AccRef acc, const pg8::Unit& u, int wr, int wc, int fr, int fq) const {
#pragma unroll
        for (int ai = 0; ai < 2; ++ai)
#pragma unroll
            for (int m = 0; m < 4; ++m) { const int row = u.pm * 256 + ai * 128 + wr * 64 + m * 16 + fr, col = u.pn * 128 + wc * 32 + 8 * fq;
                const f32x4 a0 = acc[ai][0][m][0], b0 = acc[ai][0][m][1], a1 = acc[ai][1][m][0], b1 = acc[ai][1][m][1];
                u32x4 w; w.x = cvt_pk_bf16(siluf_(a0.x) * b0.x, siluf_(a0.y) * b0.y); w.y = cvt_pk_bf16(siluf_(a0.z) * b0.z, siluf_(a0.w) * b0.w);
                w.z = cvt_pk_bf16(siluf_(a1.x) * b1.x, siluf_(a1.y) * b1.y); w.w = cvt_pk_bf16(siluf_(a1.z) * b1.z, siluf_(a1.w) * b1.w);
                *(u32x4*)(Gh + (size_t)row * FF + col) = w; }
    }
};
struct CdInOrder {
    pg8::StaticOrder so; int G, c;
    __device__ void init(int G_, int c_) { so.init(XR, 2816, G_, c_); G = G_; c = c_; }
    __device__ bool next(int i, pg8::Unit& u) const {
        const int L = i * G + c; if (L < 1408) return so.next(i, u);
        const int L2 = L - 1408; if (L2 >= 80) return false;
        u.pm = 128 + L2 / 5; u.pn = 1 + L2 % 5; return true; }
    __device__ __forceinline__ void a_ready(const pg8::Unit&) const {}
    __device__ __forceinline__ void done(const pg8::Unit&) const {}
};
template <class Epi> __device__ __forceinline__ void run_gemm_cdin(LAS unsigned char* lds, const bf16_t* A, const bf16_t* Bt, const Epi& E, int vc) {
    pg8::Gemm g; g.A = A; g.Bt = Bt; g.M = TOK; g.N = 2816; g.K = 1024;
    CdInOrder S; S.init(gridDim.x, vc);
    pg8::gemm_phase<Epi, CdInOrder, GEMM_ALIGN_EPI, GEMM_SP2>(lds, g, S, E);
    __syncthreads();
}
struct EpiResidH {
    static constexpr bool PERM = false, AFTER_DRAIN = false;
    const float* base; float* out; const float* gate; const float* g; const float* scale; bf16_t* Hn; float* SS;
    __device__ __forceinline__ void operator()(AccRef acc, const pg8::Unit& u, int wr, int wc, int fr_, int fq_) const {
        int fr = fr_, fq = fq_; asm volatile("" : "+v"(fr), "+v"(fq));
        const int row0 = u.pm * 256;
        f32x4 g4[2][2], n4[2][2];
#pragma unroll
        for (int bj = 0; bj < 2; ++bj)
#pragma unroll
            for (int n = 0; n < 2; ++n) { const int col = u.pn * 256 + bj * 128 + wc * 32 + n * 16 + 4 * fq; g4[bj][n] = *(const f32x4*)(gate + col);
                const f32x4 a = *(const f32x4*)(g + col), s = *(const f32x4*)(scale + col); n4[bj][n] = (f32x4){a.x * (1.f + s.x), a.y * (1.f + s.y), a.z * (1.f + s.z), a.w * (1.f + s.w)}; }
#pragma unroll
        for (int ai = 0; ai < 2; ++ai)
#pragma unroll
            for (int m = 0; m < 4; ++m) { const int row = row0 + ai * 128 + wr * 64 + m * 16 + fr; float sq = 0.f;
#pragma unroll
                for (int bj = 0; bj < 2; ++bj)
#pragma unroll
                    for (int n = 0; n < 2; ++n) { const int col = u.pn * 256 + bj * 128 + wc * 32 + n * 16 + 4 * fq; const f32x4 v = acc[ai][bj][m][n];
                        const f32x4 b4 = *(const f32x4*)(base + (size_t)(row - XR) * 1024 + col), gg = g4[bj][n], nn = n4[bj][n];
                        f32x4 r; r.x = b4.x + gg.x * v.x; r.y = b4.y + gg.y * v.y; r.z = b4.z + gg.z * v.z; r.w = b4.w + gg.w * v.w;
                        *(f32x4*)(out + (size_t)(row - XR) * 1024 + col) = r; sq += (r.x * r.x + r.y * r.y) + (r.z * r.z + r.w * r.w);
                        u32x2 w; w.x = cvt_pk_bf16(r.x * nn.x, r.y * nn.y); w.y = cvt_pk_bf16(r.z * nn.z, r.w * nn.w);
                        *(u32x2*)(Hn + (size_t)row * 1024 + col) = w; }
                sq += __shfl_xor(sq, 16); sq += __shfl_xor(sq, 32);
                if (fq == 0) atomicAdd(SS + row, sq); }
    }
};
struct EpiSwigluCtx {
    static constexpr bool PERM = true, AFTER_DRAIN = false;
    bf16_t* Gh; const float* SS; const float* SW;
    __device__ __forceinline__ void operator()(AccRef acc, const pg8::Unit& u, int wr, int wc, int fr, int fq) const {
        const float* sw = SW + u.pn * 256 + wc * 32 + 8 * fq;
        f32x4 sa[2], sb[2];
#pragma unroll
        for (int bj = 0; bj < 2; ++bj) { sa[bj] = *(const f32x4*)(sw + bj * 128); sb[bj] = *(const f32x4*)(sw + bj * 128 + 4); }
#pragma unroll
        for (int ai = 0; ai < 2; ++ai)
#pragma unroll
            for (int m = 0; m < 4; ++m) { const int row = u.pm * 256 + ai * 128 + wr * 64 + m * 16 + fr, col = u.pn * 128 + wc * 32 + 8 * fq; const float rstd = rsqrtf(SS[row] * (1.0f / 1024.0f) + 1e-6f);
                unsigned w[4];
#pragma unroll
                for (int bj = 0; bj < 2; ++bj) { const f32x4 a0 = acc[ai][bj][m][0], b0 = acc[ai][bj][m][1];
                    const float a[4] = {a0.x * rstd + sa[bj].x, a0.y * rstd + sa[bj].y, a0.z * rstd + sa[bj].z, a0.w * rstd + sa[bj].w}, b[4] = {b0.x * rstd + sb[bj].x, b0.y * rstd + sb[bj].y, b0.z * rstd + sb[bj].z, b0.w * rstd + sb[bj].w};
                    w[2 * bj] = cvt_pk_bf16(siluf_(a[0]) * b[0], siluf_(a[1]) * b[1]); w[2 * bj + 1] = cvt_pk_bf16(siluf_(a[2]) * b[2], siluf_(a[3]) * b[3]); }
                *(u32x4*)(Gh + (size_t)row * FF + col) = (u32x4){w[0], w[1], w[2], w[3]}; }
    }
};
struct EpiCdIn {
    static constexpr bool PERM = true, AFTER_DRAIN = false;
    bf16_t* O; const float* SS; const float* SW;
    __device__ __forceinline__ void operator()(AccRef acc, const pg8::Unit& u, int wr, int wc, int fr_, int fq_) const {
        int fr = fr_, fq = fq_; asm volatile("" : "+v"(fr), "+v"(fq));
        const bool isc = u.pm >= XR / 256;
        f32x4 s4[2][2];
#pragma unroll
        for (int bj = 0; bj < 2; ++bj)
#pragma unroll
            for (int n = 0; n < 2; ++n) s4[bj][n] = isc ? *(const f32x4*)(SW + u.pn * 256 + bj * 128 + wc * 32 + 8 * fq + 4 * n) : (f32x4){0.f, 0.f, 0.f, 0.f};
#pragma unroll
        for (int ai = 0; ai < 2; ++ai)
#pragma unroll
            for (int m = 0; m < 4; ++m) { const int row = u.pm * 256 + ai * 128 + wr * 64 + m * 16 + fr; const float rstd = isc ? rsqrtf(SS[row] * (1.0f / 1024.0f) + 1e-6f) : 1.f;
#pragma unroll
                for (int bj = 0; bj < 2; ++bj) { const int col = u.pn * 256 + bj * 128 + wc * 32 + 8 * fq;
                    const f32x4 v0 = acc[ai][bj][m][0], v1 = acc[ai][bj][m][1], t0 = s4[bj][0], t1 = s4[bj][1];
                    u32x4 w; w.x = cvt_pk_bf16(v0.x * rstd + t0.x, v0.y * rstd + t0.y); w.y = cvt_pk_bf16(v0.z * rstd + t0.z, v0.w * rstd + t0.w); w.z = cvt_pk_bf16(v1.x * rstd + t1.x, v1.y * rstd + t1.y); w.w = cvt_pk_bf16(v1.z * rstd + t1.z, v1.w * rstd + t1.w);
                    *(u32x4*)(O + (size_t)row * PW + col) = w; } }
    }
};
struct CtxOrder {
    int ntn, G, c;
    __device__ bool next(int i, pg8::Unit& u) const { const int L = i * G + c; if (L >= 16 * ntn) return false; u.pm = 128 + L / ntn; u.pn = L % ntn; return true; }
    __device__ __forceinline__ void a_ready(const pg8::Unit&) const {}
    __device__ __forceinline__ void done(const pg8::Unit&) const {}
};
template <class Epi> __device__ __forceinline__ void run_gemm_ctx(LAS unsigned char* lds, const bf16_t* A, const bf16_t* Bt, int N, int K, const Epi& E, int G, int c) {
    pg8::Gemm g; g.A = A; g.Bt = Bt; g.M = TOK; g.N = N; { int kk_ = K; asm volatile("" : "+s"(kk_)); g.K = kk_; }
    CtxOrder S; S.ntn = N / 256; S.G = G; S.c = c;
    pg8::gemm_phase<Epi, CtxOrder, GEMM_ALIGN_EPI, GEMM_SP2>(lds, g, S, E);
    __syncthreads();
}
struct PanelOrder {
    int pm, ntn;
    __device__ bool next(int i, pg8::Unit& u) const { if (i >= ntn) return false; u.pm = pm; u.pn = i; return true; }
    __device__ __forceinline__ void a_ready(const pg8::Unit&) const {}
    __device__ __forceinline__ void done(const pg8::Unit&) const {}
};
template <class Epi> __device__ __forceinline__ void run_gemm_sub(LAS unsigned char* lds, const bf16_t* A, const bf16_t* Bt, int M, int N, int K, const Epi& E, int Gsub, int c) {
    pg8::Gemm g; g.A = A; g.Bt = Bt; g.M = M; g.N = N; g.K = K;
    pg8::StaticOrder S; S.init(M, N, Gsub, c);
    pg8::gemm_phase<Epi, pg8::StaticOrder, GEMM_ALIGN_EPI, GEMM_SP2>(lds, g, S, E);
    __syncthreads();
}
template <class Epi> __device__ __forceinline__ void run_gemm(LAS unsigned char* lds, const bf16_t* A, const bf16_t* Bt, int M, int N, int K, const Epi& E, int vc) {
    pg8::Gemm g; g.A = A; g.Bt = Bt; g.M = M; g.N = N; g.K = K;
    pg8::StaticOrder S; const int G = gridDim.x; S.init(M, N, G, vc);
    pg8::gemm_phase<Epi, pg8::StaticOrder, GEMM_ALIGN_EPI, GEMM_SP2>(lds, g, S, E);
    __syncthreads();
}

__device__ __forceinline__ void sgl_rows(const Params& p, int rbeg, int rend) {
    const int lane = tidx() & 63, gw = tidx() >> 6, GW = 8;
    const bf16_t* P = (const bf16_t*)(p.ws + WS_P); unsigned* SGL = (unsigned*)((unsigned char*)p.out + DO_SGL);
    const int c = 2560 + lane * 2;
    const float mp0 = p.in[I_MUP][c], mp1 = p.in[I_MUP][c + 1], mn0 = p.in[I_MUN][c], mn1 = p.in[I_MUN][c + 1];
    for (int row = rbeg + gw; row < rend; row += GW) {
        int t, L; if (row < XR) { t = row & 2047; L = 2048; } else { t = (row - XR) & 255; L = 256; }
        const unsigned w0 = *(const unsigned*)(P + (size_t)row * PW + c);
        const unsigned wm = t > 0 ? *(const unsigned*)(P + (size_t)(row - 1) * PW + c) : 0u;
        const unsigned wp = t < L - 1 ? *(const unsigned*)(P + (size_t)(row + 1) * PW + c) : 0u;
        const float a0 = bflo(w0), a1 = bfhi(w0);
        const float u0 = a0 + mp0 * (bflo(wm) - a0) + mn0 * (bflo(wp) - a0), u1 = a1 + mp1 * (bfhi(wm) - a1) + mn1 * (bfhi(wp) - a1);
        SGL[(size_t)row * 128 + lane] = pk2(sigmoidf_(u0), sigmoidf_(u1));
        SGL[(size_t)row * 128 + 64 + lane] = 0u;
    }
}

template <int CTRL> __device__ __forceinline__ float dppf(float x) { return __builtin_bit_cast(float, __builtin_amdgcn_update_dpp(0, __builtin_bit_cast(int, x), CTRL, 0xF, 0xF, true)); }
__device__ __forceinline__ float red8(float x) { x += dppf<0xB1>(x); x += dppf<0x4E>(x); x += dppf<0x141>(x); return x; }

template <int NBLK, int KS, bool SWA = false, bool SWB = false>
__device__ __forceinline__ void wave_mma(const LAS unsigned short* A, int lda, const LAS unsigned short* B, int ldb, f32x4 (&acc)[NBLK], int fr, int fq) {
    const int fqs = (fq ^ (fr >> 2)) & 3;
#pragma unroll
    for (int ks = 0; ks < KS; ++ks) { const bf16x8 a = *(const LAS bf16x8*)(A + fr * lda + ks * 32 + (SWA ? fqs : fq) * 8);
#pragma unroll
        for (int nb = 0; nb < NBLK; ++nb) { const bf16x8 b = *(const LAS bf16x8*)(B + (nb * 16 + fr) * ldb + ks * 32 + (SWB ? fqs : fq) * 8);
            acc[nb] = __builtin_amdgcn_mfma_f32_16x16x32_bf16(b, a, acc[nb], 0, 0, 0); } }
}

typedef float f32x2 __attribute__((ext_vector_type(2)));
__device__ __forceinline__ void scan_pair(const Params& p, LAS unsigned char* lds, int pairidx) {
    const int tid = tidx(), hw = tid >> 8, ht = tid & 255, lane = tid & 63, wq = (tid >> 6) & 3, fr = lane & 15, fq = lane >> 4;
    const int unit = pairidx * 2 + hw, dir = unit & 1, bh = unit >> 1, b = bh / 12, h = bh % 12;
    const bf16_t* P = (const bf16_t*)(p.ws + WS_P);
    bf16_t* Yd = (bf16_t*)((unsigned char*)p.out + (dir ? DO_YB : DO_YF));
    float* BON = (float*)(p.ws + WS_BONUS);
    LAS unsigned char* Lh = lds + hw * 73728;
    LAS float* FW = (LAS float*)Lh; LAS float* FBB = FW + 2048; LAS float* FKK = FBB + 2048; LAS float* FR = FKK + 2048; LAS float* FKD = FR + 2048; LAS float* FV = FKD + 2048;
    LAS unsigned short* RAW = (LAS unsigned short*)Lh;
    LAS unsigned short* TWb = (LAS unsigned short*)(Lh + 49152); LAS unsigned short* ALb = TWb + 32 * 72;
    LAS float* YBUF = (LAS float*)(Lh + 58368);
    LAS float* CC = (LAS float*)(Lh + 66560);
    LAS float* CST = (LAS float*)(Lh + 66816);
    LAS float* MU = (LAS float*)(Lh + 68096);
    __syncthreads();
    if (ht < 64) { const int j = ht; CST[j] = p.in[I_W0][dir * 768 + h * 64 + j]; CST[64 + j] = p.in[I_A0][dir * 768 + h * 64 + j]; CST[128 + j] = p.in[I_KK][h * 64 + j]; CST[192 + j] = p.in[I_KA][h * 64 + j]; CST[256 + j] = p.in[I_RK][h * 64 + j]; }
    for (int i = ht; i < 320; i += 256) { const int s = i >> 6, j = i & 63; const int col = s < 3 ? s * 768 + h * 64 + j : (s == 3 ? 2304 + dir * 64 + j : 2432 + dir * 64 + j); MU[i] = p.in[I_MUP][col]; MU[320 + i] = p.in[I_MUN][col]; }
    const int mm = wq & 1, np = wq >> 1;
    bf16x8 Bf[2][2];
    { const float* Wm = (mm ? p.in[I_A2] : p.in[I_W2]) + (size_t)dir * 64 * 768 + h * 64;
#pragma unroll
      for (int n2 = 0; n2 < 2; ++n2)
#pragma unroll
          for (int ks = 0; ks < 2; ++ks)
#pragma unroll
              for (int e = 0; e < 8; ++e) Bf[n2][ks][e] = (short)f2bf(Wm[(size_t)(ks * 32 + fq * 8 + e) * 768 + (np * 2 + n2) * 16 + fr]); }
    const int rl = lane >> 3, kc = lane & 7, vr0 = wq * 16 + rl * 2;
    f32x4 Sacc[4];
#pragma unroll
    for (int nb = 0; nb < 4; ++nb) Sacc[nb] = (f32x4){0.f, 0.f, 0.f, 0.f};
    LAS unsigned short* cAl = (LAS unsigned short*)Lh; LAS unsigned short* cBe = cAl + 32 * 72; LAS unsigned short* cKa = cBe + 32 * 72; LAS unsigned short* cRh = cKa + 32 * 72;
    LAS unsigned short* cKT = (LAS unsigned short*)(Lh + 18432); LAS unsigned short* cNBT = cKT + 2048; LAS unsigned short* cVT = cNBT + 2048; LAS unsigned short* cUT = cVT + 2048;
    LAS float* cLL = (LAS float*)(Lh + 34816);
    LAS unsigned short* cAK = (LAS unsigned short*)(Lh + 38912); LAS unsigned short* cRK = cAK + 1280; LAS unsigned short* cNRB = cRK + 1280;
    LAS unsigned short* cS0 = (LAS unsigned short*)(Lh + 46592);
    LAS float* cRHS = YBUF;
    LAS unsigned short* cLb = (LAS unsigned short*)(Lh + 55808);
    LAS float* GL = CC;
    u32x4 pre[6];
    auto blk_geom = [&](int blk, int& base, int& L, int& t0) { int lb; if (blk < 8) { base = XR + b * 256; L = 256; lb = blk; } else { base = b * 2048; L = 2048; lb = blk - 8; } t0 = dir ? (L - 32 - lb * 32) : lb * 32; };
    auto prefetch = [&](int blk) { int base, L, t0; blk_geom(blk, base, L, t0);
#pragma unroll
        for (int q = 0; q < 6; ++q) { const int c = ht + 256 * q; pre[q] = (u32x4){0u, 0u, 0u, 0u};
            if (c < 1360) { const int rr = c / 40, cc = c % 40, seg = cc >> 3, off = (cc & 7) * 8; const int t = t0 - 1 + rr;
                const int col = seg < 3 ? seg * 768 + h * 64 + off : (seg == 3 ? 2304 + dir * 64 + off : 2432 + dir * 64 + off);
                if (t >= 0 && t < L) pre[q] = *(const u32x4*)(P + (size_t)(base + t) * PW + col); } } };
    auto flush = [&](int blk) { int base, L, t0; blk_geom(blk, base, L, t0); const int t = ht >> 3, j8 = (ht & 7) * 8;
        const f32x4 y0 = *(const LAS f32x4*)(YBUF + t * 64 + j8), y1 = *(const LAS f32x4*)(YBUF + t * 64 + j8 + 4);
        u32x4 w; w.x = pk2(y0.x, y0.y); w.y = pk2(y0.z, y0.w); w.z = pk2(y1.x, y1.y); w.w = pk2(y1.z, y1.w);
        __builtin_nontemporal_store(w, (u32x4*)(Yd + (size_t)(base + t0 + t) * 768 + h * 64 + j8)); };
    prefetch(0);
    for (int blk = 0; blk < 72; ++blk) {
        int base, L, t0; blk_geom(blk, base, L, t0);
        __syncthreads();
        if (blk > 0) flush(blk - 1);
#pragma unroll
        for (int q = 0; q < 6; ++q) { const int c = ht + 256 * q; if (c < 1360) *(LAS u32x4*)(RAW + c * 8) = pre[q]; }
        __syncthreads();
        { const int jp = ht & 31, tg = ht >> 5;
#pragma unroll
          for (int s = 0; s < 5; ++s) { unsigned w[6];
#pragma unroll
              for (int rr = 0; rr < 6; ++rr) w[rr] = *(const LAS unsigned*)(RAW + (tg * 4 + rr) * 320 + s * 64 + 2 * jp);
              const float mp0 = MU[s * 64 + 2 * jp], mp1 = MU[s * 64 + 2 * jp + 1], mn0 = MU[320 + s * 64 + 2 * jp], mn1 = MU[320 + s * 64 + 2 * jp + 1];
#pragma unroll
              for (int tt = 0; tt < 4; ++tt) { const int t = tg * 4 + tt; const float a0 = bflo(w[tt + 1]), a1 = bfhi(w[tt + 1]);
                  const float u0 = a0 + mp0 * (bflo(w[tt]) - a0) + mn0 * (bflo(w[tt + 2]) - a0), u1 = a1 + mp1 * (bfhi(w[tt]) - a1) + mn1 * (bfhi(w[tt + 2]) - a1);
                  if (s == 0) *(LAS f32x2*)(FR + t * 64 + 2 * jp) = (f32x2){u0, u1};
                  else if (s == 1) *(LAS f32x2*)(FKD + t * 64 + 2 * jp) = (f32x2){u0, u1};
                  else if (s == 2) *(LAS f32x2*)(FV + t * 64 + 2 * jp) = (f32x2){u0, u1};
                  else if (s == 3) *(LAS unsigned*)(TWb + t * 72 + 2 * jp) = pk2(2.f * sigmoidf_(2.f * u0) - 1.f, 2.f * sigmoidf_(2.f * u1) - 1.f);
                  else *(LAS unsigned*)(ALb + t * 72 + 2 * jp) = pk2(u0, u1); } } }
        __syncthreads();
        {
#pragma unroll
          for (int mb = 0; mb < 2; ++mb) { f32x4 acc[2] = {{0.f, 0.f, 0.f, 0.f}, {0.f, 0.f, 0.f, 0.f}};
              const LAS unsigned short* A = (mm ? ALb : TWb) + mb * 16 * 72;
#pragma unroll
              for (int ks = 0; ks < 2; ++ks) { const bf16x8 a = *(const LAS bf16x8*)(A + fr * 72 + ks * 32 + fq * 8);
#pragma unroll
                  for (int n2 = 0; n2 < 2; ++n2) acc[n2] = __builtin_amdgcn_mfma_f32_16x16x32_bf16(Bf[n2][ks], a, acc[n2], 0, 0, 0); }
              LAS float* O = (mm ? FBB : FW) + (mb * 16 + fr) * 64 + np * 32 + fq * 4;
#pragma unroll
              for (int n2 = 0; n2 < 2; ++n2) *(LAS f32x4*)(O + n2 * 16) = acc[n2]; } }
        __syncthreads();
        { const int t = ht >> 3, jg = ht & 7, o = t * 64 + jg * 8;
          float wp[8], ap[8], kv[8], rv[8];
          { const f32x4 x0 = *(const LAS f32x4*)(FW + o), x1 = *(const LAS f32x4*)(FW + o + 4); wp[0] = x0.x; wp[1] = x0.y; wp[2] = x0.z; wp[3] = x0.w; wp[4] = x1.x; wp[5] = x1.y; wp[6] = x1.z; wp[7] = x1.w; }
          { const f32x4 x0 = *(const LAS f32x4*)(FBB + o), x1 = *(const LAS f32x4*)(FBB + o + 4); ap[0] = x0.x; ap[1] = x0.y; ap[2] = x0.z; ap[3] = x0.w; ap[4] = x1.x; ap[5] = x1.y; ap[6] = x1.z; ap[7] = x1.w; }
          { const f32x4 x0 = *(const LAS f32x4*)(FKD + o), x1 = *(const LAS f32x4*)(FKD + o + 4); kv[0] = x0.x; kv[1] = x0.y; kv[2] = x0.z; kv[3] = x0.w; kv[4] = x1.x; kv[5] = x1.y; kv[6] = x1.z; kv[7] = x1.w; }
          { const f32x4 x0 = *(const LAS f32x4*)(FR + o), x1 = *(const LAS f32x4*)(FR + o + 4); rv[0] = x0.x; rv[1] = x0.y; rv[2] = x0.z; rv[3] = x0.w; rv[4] = x1.x; rv[5] = x1.y; rv[6] = x1.z; rv[7] = x1.w; }
          float dec[8], av[8], kkv[8], kd[8], ss = 0.f, bs = 0.f;
#pragma unroll
          for (int e = 0; e < 8; ++e) { const int j = jg * 8 + e;
              dec[e] = __expf(-0.6065306597126334f * sigmoidf_(CST[j] + wp[e]));
              av[e] = sigmoidf_(CST[64 + j] + ap[e]);
              kkv[e] = kv[e] * CST[128 + j]; ss += kkv[e] * kkv[e];
              kd[e] = kv[e] * (1.f + (av[e] - 1.f) * CST[192 + j]);
              bs += rv[e] * kd[e] * CST[256 + j]; }
          ss = red8(ss); const float inv = rsqrtf(ss + 1e-12f);
          float bb[8];
#pragma unroll
          for (int e = 0; e < 8; ++e) { kkv[e] *= inv; bb[e] = kkv[e] * av[e]; }
          if (dir == 0) { bs = red8(bs); if (jg == 0) BON[(size_t)(base + t0 + t) * 12 + h] = bs; }
          *(LAS f32x4*)(FW + o) = (f32x4){dec[0], dec[1], dec[2], dec[3]}; *(LAS f32x4*)(FW + o + 4) = (f32x4){dec[4], dec[5], dec[6], dec[7]};
          *(LAS f32x4*)(FBB + o) = (f32x4){bb[0], bb[1], bb[2], bb[3]}; *(LAS f32x4*)(FBB + o + 4) = (f32x4){bb[4], bb[5], bb[6], bb[7]};
          *(LAS f32x4*)(FKK + o) = (f32x4){kkv[0], kkv[1], kkv[2], kkv[3]}; *(LAS f32x4*)(FKK + o + 4) = (f32x4){kkv[4], kkv[5], kkv[6], kkv[7]};
          *(LAS f32x4*)(FKD + o) = (f32x4){kd[0], kd[1], kd[2], kd[3]}; *(LAS f32x4*)(FKD + o + 4) = (f32x4){kd[4], kd[5], kd[6], kd[7]};
          *(LAS f32x4*)(FR + o) = (f32x4){rv[0], rv[1], rv[2], rv[3]}; *(LAS f32x4*)(FR + o + 4) = (f32x4){rv[4], rv[5], rv[6], rv[7]}; }
        __syncthreads();
        { const int k = ht & 63, part = ht >> 6;
          float g = 1.f;
#pragma unroll
          for (int i2 = 0; i2 < 24; ++i2) { const int t = dir ? 31 - i2 : i2; const float wv = FW[t * 64 + k]; g = (i2 < 8 * part) ? g * wv : g; }
          float al[8], be[8], ka[8], rh[8], vt[8];
#pragma unroll
          for (int e = 0; e < 8; ++e) { const int i = part * 8 + e, t = dir ? 31 - i : i; const int o = t * 64 + k;
              const float gp = g; g *= FW[o]; const float inv = __builtin_amdgcn_rcpf(g);
              al[e] = gp * FKK[o]; be[e] = FBB[o] * inv; ka[e] = FKD[o] * inv; rh[e] = (dir ? gp : g) * FR[o]; vt[e] = FV[o]; }
          __syncthreads();
#pragma unroll
          for (int e = 0; e < 8; ++e) { const int i = part * 8 + e; cAl[i * 72 + k] = f2bf(al[e]); cBe[i * 72 + k] = f2bf(be[e]); cKa[i * 72 + k] = f2bf(ka[e]); cRh[i * 72 + k] = f2bf(rh[e]); }
          { u32x4 w; w.x = pk2(ka[0], ka[1]); w.y = pk2(ka[2], ka[3]); w.z = pk2(ka[4], ka[5]); w.w = pk2(ka[6], ka[7]); *(LAS u32x4*)(cKT + k * 32 + ((part ^ (k >> 2)) & 3) * 8) = w; }
          { u32x4 w; w.x = pk2(-be[0], -be[1]); w.y = pk2(-be[2], -be[3]); w.z = pk2(-be[4], -be[5]); w.w = pk2(-be[6], -be[7]); *(LAS u32x4*)(cNBT + k * 32 + ((part ^ (k >> 2)) & 3) * 8) = w; }
          { u32x4 w; w.x = pk2(vt[0], vt[1]); w.y = pk2(vt[2], vt[3]); w.z = pk2(vt[4], vt[5]); w.w = pk2(vt[6], vt[7]); *(LAS u32x4*)(cVT + k * 32 + ((part ^ (k >> 2)) & 3) * 8) = w; }
          if (part == 3) GL[k] = g;
#pragma unroll
          for (int nb = 0; nb < 4; ++nb) { u32x2 w; w.x = pk2(Sacc[nb].x, Sacc[nb].y); w.y = pk2(Sacc[nb].z, Sacc[nb].w); *(LAS u32x2*)(cS0 + (wq * 16 + fr) * 72 + nb * 16 + fq * 4) = w; } }
        __syncthreads();
        const int cm = wq & 1, cset = wq >> 1, ci = cm * 16 + fr;
        { f32x4 accA[4], l2[2], k2[2];
#pragma unroll
          for (int nb = 0; nb < 4; ++nb) accA[nb] = (f32x4){0.f, 0.f, 0.f, 0.f};
#pragma unroll
          for (int nb = 0; nb < 2; ++nb) { l2[nb] = (f32x4){0.f, 0.f, 0.f, 0.f}; k2[nb] = (f32x4){0.f, 0.f, 0.f, 0.f}; }
          const LAS unsigned short* Arow = (cset ? cRh : cAl) + cm * 16 * 72;
          wave_mma<2, 2>(Arow, 72, cBe, 72, l2, fr, fq);
          wave_mma<2, 2>(Arow, 72, cKa, 72, k2, fr, fq);
          if (cset == 0) wave_mma<4, 2>(Arow, 72, cS0, 72, accA, fr, fq);
#pragma unroll
          for (int nb = 0; nb < 2; ++nb) { float lv[4] = {l2[nb].x, l2[nb].y, l2[nb].z, l2[nb].w}, kv2[4] = {k2[nb].x, k2[nb].y, k2[nb].z, k2[nb].w};
#pragma unroll
              for (int e = 0; e < 4; ++e) { const int j = nb * 16 + fq * 4 + e; const bool keep = cset ? (dir ? (j < ci) : (j <= ci)) : (j < ci);
                  lv[e] = keep ? lv[e] : 0.f; kv2[e] = keep ? kv2[e] : 0.f; }
              if (cset == 0) { *(LAS f32x4*)(cLL + ci * 32 + nb * 16 + fq * 4) = (f32x4){lv[0], lv[1], lv[2], lv[3]};
                  if (cm == 1) { u32x2 wl; wl.x = nb == 0 ? pk2(lv[0], lv[1]) : 0u; wl.y = nb == 0 ? pk2(lv[2], lv[3]) : 0u; *(LAS u32x2*)(cLb + fr * 40 + nb * 16 + fq * 4) = wl; }
                  u32x2 w; w.x = pk2(kv2[0], kv2[1]); w.y = pk2(kv2[2], kv2[3]); *(LAS u32x2*)(cAK + ci * 40 + nb * 16 + fq * 4) = w; }
              else { u32x2 w; w.x = pk2(-lv[0], -lv[1]); w.y = pk2(-lv[2], -lv[3]); *(LAS u32x2*)(cNRB + ci * 40 + nb * 16 + fq * 4) = w;
                  u32x2 w2; w2.x = pk2(kv2[0], kv2[1]); w2.y = pk2(kv2[2], kv2[3]); *(LAS u32x2*)(cRK + ci * 40 + nb * 16 + fq * 4) = w2; } }
          asm volatile("s_waitcnt lgkmcnt(0)" ::: "memory");
          if (cset == 0) { wave_mma<4, 1, false, true>(cAK + cm * 16 * 40, 40, cVT, 32, accA, fr, fq);
#pragma unroll
              for (int nb = 0; nb < 4; ++nb) *(LAS f32x4*)(cRHS + ci * 64 + nb * 16 + fq * 4) = accA[nb]; } }
        __syncthreads();
        if (wq == hw) { const int v = lane; int zz[6] = {0, 0, 0, 0, 0, 0};
            float u[16];
#pragma unroll
            for (int i = 0; i < 16; ++i) u[i] = 0.f;
#pragma unroll
            for (int i = 0; i < 16; ++i) { const int z = zz[i % 6]; float a0 = cRHS[i * 64 + v + z], a1 = 0.f;
#pragma unroll
                for (int j4 = 0; j4 < (i + 3) / 4; ++j4) { const f32x4 l = *(const LAS f32x4*)(cLL + i * 32 + j4 * 4 + z);
                    a0 -= l.x * u[j4 * 4]; a1 -= l.y * u[j4 * 4 + 1]; a0 -= l.z * u[j4 * 4 + 2]; a1 -= l.w * u[j4 * 4 + 3]; }
                u[i] = a0 + a1;
                asm volatile("" : "+v"(zz[i % 6]) : "v"(u[i])); }
            { u32x4 w; w.x = pk2(u[0], u[1]); w.y = pk2(u[2], u[3]); w.z = pk2(u[4], u[5]); w.w = pk2(u[6], u[7]); *(LAS u32x4*)(cUT + v * 32 + ((0 ^ (v >> 2)) & 3) * 8) = w;
              u32x4 w1; w1.x = pk2(u[8], u[9]); w1.y = pk2(u[10], u[11]); w1.z = pk2(u[12], u[13]); w1.w = pk2(u[14], u[15]); *(LAS u32x4*)(cUT + v * 32 + ((1 ^ (v >> 2)) & 3) * 8) = w1;
              *(LAS u32x4*)(cUT + v * 32 + ((2 ^ (v >> 2)) & 3) * 8) = (u32x4){0u, 0u, 0u, 0u}; *(LAS u32x4*)(cUT + v * 32 + ((3 ^ (v >> 2)) & 3) * 8) = (u32x4){0u, 0u, 0u, 0u}; }
            asm volatile("s_waitcnt lgkmcnt(0)" ::: "memory");
            { f32x4 cacc[4];
#pragma unroll
              for (int nb = 0; nb < 4; ++nb) cacc[nb] = (f32x4){0.f, 0.f, 0.f, 0.f};
              wave_mma<4, 1, false, true>(cLb, 40, cUT, 32, cacc, fr, fq);
#pragma unroll
              for (int nb = 0; nb < 4; ++nb) { LAS f32x4* rp = (LAS f32x4*)(cRHS + (16 + fr) * 64 + nb * 16 + fq * 4); f32x4 r = *rp; r.x -= cacc[nb].x; r.y -= cacc[nb].y; r.z -= cacc[nb].z; r.w -= cacc[nb].w; *rp = r; } }
            asm volatile("s_waitcnt lgkmcnt(0)" ::: "memory");
#pragma unroll
            for (int i = 0; i < 16; ++i) u[i] = 0.f;
#pragma unroll
            for (int i = 0; i < 16; ++i) { const int z = zz[i % 6]; float a0 = cRHS[(16 + i) * 64 + v + z], a1 = 0.f;
#pragma unroll
                for (int j4 = 0; j4 < (i + 3) / 4; ++j4) { const f32x4 l = *(const LAS f32x4*)(cLL + (16 + i) * 32 + 16 + j4 * 4 + z);
                    a0 -= l.x * u[j4 * 4]; a1 -= l.y * u[j4 * 4 + 1]; a0 -= l.z * u[j4 * 4 + 2]; a1 -= l.w * u[j4 * 4 + 3]; }
                u[i] = a0 + a1;
                asm volatile("" : "+v"(zz[i % 6]) : "v"(u[i])); }
            { u32x4 w; w.x = pk2(u[0], u[1]); w.y = pk2(u[2], u[3]); w.z = pk2(u[4], u[5]); w.w = pk2(u[6], u[7]); *(LAS u32x4*)(cUT + v * 32 + ((2 ^ (v >> 2)) & 3) * 8) = w;
              u32x4 w1; w1.x = pk2(u[8], u[9]); w1.y = pk2(u[10], u[11]); w1.z = pk2(u[12], u[13]); w1.w = pk2(u[14], u[15]); *(LAS u32x4*)(cUT + v * 32 + ((3 ^ (v >> 2)) & 3) * 8) = w1; } }
        __syncthreads();
        if (blk + 1 < 72) prefetch(blk + 1);
        if (cset == 1) { f32x4 accA[4];
#pragma unroll
            for (int nb = 0; nb < 4; ++nb) accA[nb] = (f32x4){0.f, 0.f, 0.f, 0.f};
            wave_mma<4, 2>(cRh + cm * 16 * 72, 72, cS0, 72, accA, fr, fq);
            wave_mma<4, 1, false, true>(cRK + cm * 16 * 40, 40, cVT, 32, accA, fr, fq);
            wave_mma<4, 1, false, true>(cNRB + cm * 16 * 40, 40, cUT, 32, accA, fr, fq); const int t = dir ? 31 - ci : ci;
#pragma unroll
            for (int nb = 0; nb < 4; ++nb) *(LAS f32x4*)(YBUF + t * 64 + nb * 16 + fq * 4) = accA[nb]; }
        wave_mma<4, 1, true, true>(cVT + wq * 16 * 32, 32, cKT, 32, Sacc, fr, fq);
        wave_mma<4, 1, true, true>(cUT + wq * 16 * 32, 32, cNBT, 32, Sacc, fr, fq);
#pragma unroll
        for (int nb = 0; nb < 4; ++nb) { const f32x4 g4 = *(const LAS f32x4*)(GL + nb * 16 + fq * 4); Sacc[nb].x *= g4.x; Sacc[nb].y *= g4.y; Sacc[nb].z *= g4.z; Sacc[nb].w *= g4.w; }
    }
    __syncthreads();
    flush(71);
}
__device__ __forceinline__ void phase_scan(const Params& p, LAS unsigned char* lds) {
    const int bid = blockIdx.x, G = gridDim.x;
    const int NS = G >= 256 ? 192 : G;
    if (bid < NS) for (int w = bid; w < 192; w += NS) scan_pair(p, lds, w);
    const bool split = G >= 256; const int Gd = split ? G - 192 : G, cd = split ? bid - 192 : bid;
    if (!split || bid >= 192) {
        bf16_t* HM = (bf16_t*)(p.ws + WS_HM);
        EpiDft E; E.MX = HM; E.rowbase = 0; E.L = 2048; E.scale = 0.0027621358640099515f;
        run_gemm_sub(lds, (const bf16_t*)(p.ws + WS_TX), (const bf16_t*)(p.ws + WS_VTX), 2048, 4096, 4096, E, Gd, cd);
        EpiDft E2; E2.MX = HM; E2.rowbase = XR; E2.L = 256; E2.scale = 0.0078125f;
        run_gemm_sub(lds, (const bf16_t*)(p.ws + WS_TC), (const bf16_t*)(p.ws + WS_VTC), 256, 4096, 512, E2, Gd, cd);
        for (int pm = cd; pm < TOK / 256; pm += Gd) {
            sgl_rows(p, pm * 256, pm * 256 + 256);
            __threadfence(); __syncthreads();
            pg8::Gemm g; g.A = (const bf16_t*)((unsigned char*)p.out + DO_SGL); g.Bt = (const bf16_t*)(p.ws + WS_G2); g.M = TOK; g.N = 768; { int kk_ = 256; asm volatile("" : "+s"(kk_)); g.K = kk_; }
            PanelOrder S; S.pm = pm; S.ntn = 3; EpiBf16Plain Eg; Eg.O = (bf16_t*)(p.ws + WS_GG); Eg.ldo = 768;
            pg8::gemm_phase<EpiBf16Plain, PanelOrder, GEMM_ALIGN_EPI, GEMM_SP2>(lds, g, S, Eg);
            __syncthreads();
        }
        prep_transposes(p, lds, 672, 3296, cd, Gd);
        prep_transposes(p, lds, 4704, 5408, cd, Gd);
        prep_transposes(p, lds, 3296, 4704, cd, Gd);
        prep_transposes(p, lds, 5408, 6112, cd, Gd);
    }
}

__device__ __forceinline__ void phase_rwkv_out(const Params& p) {
    const int lane = tidx() & 63, gw = blockIdx.x * 8 + (tidx() >> 6), GW = gridDim.x * 8;
    const bf16_t* P = (const bf16_t*)(p.ws + WS_P); const bf16_t* YF = (const bf16_t*)((unsigned char*)p.out + DO_YF); const bf16_t* YB = (const bf16_t*)((unsigned char*)p.out + DO_YB);
    const bf16_t* GG = (const bf16_t*)(p.ws + WS_GG); const float* BON = (const float*)(p.ws + WS_BONUS); bf16_t* MX = (bf16_t*)(p.ws + WS_HM);
    for (int row0 = gw * 2; row0 < TOK; row0 += GW * 2) {
#pragma unroll
        for (int ps = 0; ps < 3; ++ps) {
            const int s = ps * 64 + lane, rsel = s >= 96 ? 1 : 0, ch = (s - rsel * 96) * 8, hh = ch >> 6; const int row = row0 + rsel;
            int t, L; if (row < XR) { t = row & 2047; L = 2048; } else { t = (row - XR) & 255; L = 256; }
            const u32x4 yf = __builtin_nontemporal_load((const u32x4*)(YF + (size_t)row * 768 + ch)), yb = __builtin_nontemporal_load((const u32x4*)(YB + (size_t)row * 768 + ch)), gg = __builtin_nontemporal_load((const u32x4*)(GG + (size_t)row * 768 + ch));
            const int vc = 1536 + ch;
            const u32x4 v0 = *(const u32x4*)(P + (size_t)row * PW + vc);
            const u32x4 vm = t > 0 ? *(const u32x4*)(P + (size_t)(row - 1) * PW + vc) : (u32x4){0u, 0u, 0u, 0u};
            const u32x4 vp = t < L - 1 ? *(const u32x4*)(P + (size_t)(row + 1) * PW + vc) : (u32x4){0u, 0u, 0u, 0u};
            const unsigned yfw[4] = {yf.x, yf.y, yf.z, yf.w}, ybw[4] = {yb.x, yb.y, yb.z, yb.w}, ggw[4] = {gg.x, gg.y, gg.z, gg.w}, v0w[4] = {v0.x, v0.y, v0.z, v0.w}, vmw[4] = {vm.x, vm.y, vm.z, vm.w}, vpw[4] = {vp.x, vp.y, vp.z, vp.w};
            float y[8]; float sm = 0.f;
#pragma unroll
            for (int e = 0; e < 4; ++e) { y[2 * e] = bflo(yfw[e]) + bflo(ybw[e]); y[2 * e + 1] = bfhi(yfw[e]) + bfhi(ybw[e]); sm += y[2 * e] + y[2 * e + 1]; }
            const float mu = red8(sm) * (1.f / 64.f); float q = 0.f;
#pragma unroll
            for (int e = 0; e < 8; ++e) { y[e] -= mu; q += y[e] * y[e]; }
            const float rs = rsqrtf(red8(q) * (1.f / 64.f) + 64e-5f);
            const float bon = BON[(size_t)row * 12 + hh];
            float mp[8], mn[8], lg[8], lb[8];
            { const f32x4 a0 = *(const f32x4*)(p.in[I_MUP] + vc), a1 = *(const f32x4*)(p.in[I_MUP] + vc + 4), b0 = *(const f32x4*)(p.in[I_MUN] + vc), b1 = *(const f32x4*)(p.in[I_MUN] + vc + 4);
              const f32x4 c0 = *(const f32x4*)(p.in[I_LNXG] + ch), c1 = *(const f32x4*)(p.in[I_LNXG] + ch + 4), d0 = *(const f32x4*)(p.in[I_LNXB] + ch), d1 = *(const f32x4*)(p.in[I_LNXB] + ch + 4);
              mp[0] = a0.x; mp[1] = a0.y; mp[2] = a0.z; mp[3] = a0.w; mp[4] = a1.x; mp[5] = a1.y; mp[6] = a1.z; mp[7] = a1.w;
              mn[0] = b0.x; mn[1] = b0.y; mn[2] = b0.z; mn[3] = b0.w; mn[4] = b1.x; mn[5] = b1.y; mn[6] = b1.z; mn[7] = b1.w;
              lg[0] = c0.x; lg[1] = c0.y; lg[2] = c0.z; lg[3] = c0.w; lg[4] = c1.x; lg[5] = c1.y; lg[6] = c1.z; lg[7] = c1.w;
              lb[0] = d0.x; lb[1] = d0.y; lb[2] = d0.z; lb[3] = d0.w; lb[4] = d1.x; lb[5] = d1.y; lb[6] = d1.z; lb[7] = d1.w; }
            float o8[8];
#pragma unroll
            for (int e = 0; e < 8; ++e) { const unsigned w0 = v0w[e >> 1], wm = vmw[e >> 1], wp = vpw[e >> 1], wg = ggw[e >> 1];
                const float p0 = (e & 1) ? bfhi(w0) : bflo(w0), pm = (e & 1) ? bfhi(wm) : bflo(wm), pp = (e & 1) ? bfhi(wp) : bflo(wp), g1 = (e & 1) ? bfhi(wg) : bflo(wg);
                const float uv = p0 + mp[e] * (pm - p0) + mn[e] * (pp - p0);
                const float yn = y[e] * rs * lg[e] + lb[e]; o8[e] = (yn + bon * uv) * g1; }
            u32x4 w; w.x = pk2(o8[0], o8[1]); w.y = pk2(o8[2], o8[3]); w.z = pk2(o8[4], o8[5]); w.w = pk2(o8[6], o8[7]);
            *(u32x4*)(MX + (size_t)row * 1024 + 256 + ch) = w;
        }
    }
}
__device__ __forceinline__ void retention_unit(const Params& p, LAS unsigned char* lds, int unit) {
    const int tid = tidx(), lane = tid & 63, wave = tid >> 6, fr = lane & 15, fq = lane >> 4;
    const int dir = unit / 96, rem = unit % 96, b = rem / 6, h = rem % 6;
    const bf16_t* P = (const bf16_t*)(p.ws + WS_P); const float* RP = (const float*)(p.ws + WS_ROPE);
    bf16_t* Yd = (bf16_t*)(p.ws + (dir ? WS_YRB : WS_YRF));
    constexpr int LQ = 72, LT = 136;
    LAS unsigned short* Qs = (LAS unsigned short*)lds;
    LAS unsigned short* Ks = Qs + 128 * LQ;
    LAS unsigned short* Ss = Qs;
    LAS unsigned short* KTs = Ks + 128 * LQ;
    LAS unsigned short* VTs = KTs + 64 * LT;
    LAS unsigned short* RTs = VTs + 128 * LT;
    const float lg = -__expf(p.in[I_DECAYP][dir * 6 + h]);
    const float cdec = __expf(lg * 128.f);
    f32x4 racc[4];
#pragma unroll
    for (int nb = 0; nb < 4; ++nb) racc[nb] = (f32x4){0.f, 0.f, 0.f, 0.f};
    __syncthreads();
    for (int i = tid; i < 128 * LQ; i += NT) RTs[i] = 0;
    u32x4 pk_lo, pk_hi, pq_lo, pq_hi, pv[4]; f32x4 pc[2], ps[2];
    auto chunk_geom = [&](int ch, bool& isctx, int& L, int& base, int& n) { isctx = ch < 2; L = isctx ? 256 : 2048; base = isctx ? XR + b * 256 : b * 2048; n = isctx ? ch : ch - 2; };
    auto prefetch = [&](int ch) { bool isctx; int L, base, n; chunk_geom(ch, isctx, L, base, n);
        const int i = tid & 127, part = tid >> 7; const int pos = n * 128 + i; const int t = dir ? (L - 1 - pos) : pos; const size_t ro = (size_t)(base + t) * PW;
        pk_lo = *(const u32x4*)(P + ro + 384 + h * 64 + part * 8); pk_hi = *(const u32x4*)(P + ro + 384 + h * 64 + 32 + part * 8);
#pragma unroll
        for (int q = 0; q < 4; ++q) pv[q] = *(const u32x4*)(P + ro + 768 + h * 128 + part * 32 + q * 8);
        if (!isctx) { pq_lo = *(const u32x4*)(P + ro + h * 64 + part * 8); pq_hi = *(const u32x4*)(P + ro + h * 64 + 32 + part * 8);
            pc[0] = *(const f32x4*)(RP + t * 64 + part * 8); pc[1] = *(const f32x4*)(RP + t * 64 + part * 8 + 4); ps[0] = *(const f32x4*)(RP + t * 64 + 32 + part * 8); ps[1] = *(const f32x4*)(RP + t * 64 + 32 + part * 8 + 4); } };
    prefetch(0);
    for (int ch = 0; ch < 18; ++ch) {
        bool isctx; int L, base, n; chunk_geom(ch, isctx, L, base, n);
        __syncthreads();
        {
            const int i = tid & 127, part = tid >> 7;
            const float kdcy = __expf(lg * (float)(127 - i)) * 0.125f;
            const float cv[8] = {pc[0].x, pc[0].y, pc[0].z, pc[0].w, pc[1].x, pc[1].y, pc[1].z, pc[1].w}, sv8[8] = {ps[0].x, ps[0].y, ps[0].z, ps[0].w, ps[1].x, ps[1].y, ps[1].z, ps[1].w};
            { const unsigned lw[4] = {pk_lo.x, pk_lo.y, pk_lo.z, pk_lo.w}, hw[4] = {pk_hi.x, pk_hi.y, pk_hi.z, pk_hi.w}; float o1[8], o2[8];
#pragma unroll
              for (int e = 0; e < 8; ++e) { const float t1 = (e & 1) ? bfhi(lw[e >> 1]) : bflo(lw[e >> 1]), t2 = (e & 1) ? bfhi(hw[e >> 1]) : bflo(hw[e >> 1]); const int d = part * 8 + e;
                  const float c = isctx ? 1.f : cv[e], s = isctx ? 0.f : sv8[e];
                  o1[e] = t1 * c - t2 * s; o2[e] = t1 * s + t2 * c;
                  KTs[d * LT + i] = f2bf(o1[e] * kdcy); KTs[(d + 32) * LT + i] = f2bf(o2[e] * kdcy); }
              if (!isctx) { u32x4 w; w.x = pk2(o1[0] * 0.125f, o1[1] * 0.125f); w.y = pk2(o1[2] * 0.125f, o1[3] * 0.125f); w.z = pk2(o1[4] * 0.125f, o1[5] * 0.125f); w.w = pk2(o1[6] * 0.125f, o1[7] * 0.125f);
                  *(LAS u32x4*)(Ks + i * LQ + part * 8) = w;
                  u32x4 w2; w2.x = pk2(o2[0] * 0.125f, o2[1] * 0.125f); w2.y = pk2(o2[2] * 0.125f, o2[3] * 0.125f); w2.z = pk2(o2[4] * 0.125f, o2[5] * 0.125f); w2.w = pk2(o2[6] * 0.125f, o2[7] * 0.125f);
                  *(LAS u32x4*)(Ks + i * LQ + 32 + part * 8) = w2; } }
            if (!isctx) { const unsigned lw[4] = {pq_lo.x, pq_lo.y, pq_lo.z, pq_lo.w}, hw[4] = {pq_hi.x, pq_hi.y, pq_hi.z, pq_hi.w}; float o1[8], o2[8];
#pragma unroll
              for (int e = 0; e < 8; ++e) { const float t1 = (e & 1) ? bfhi(lw[e >> 1]) : bflo(lw[e >> 1]), t2 = (e & 1) ? bfhi(hw[e >> 1]) : bflo(hw[e >> 1]);
                  o1[e] = t1 * cv[e] - t2 * sv8[e]; o2[e] = t1 * sv8[e] + t2 * cv[e]; }
              u32x4 w; w.x = pk2(o1[0], o1[1]); w.y = pk2(o1[2], o1[3]); w.z = pk2(o1[4], o1[5]); w.w = pk2(o1[6], o1[7]); *(LAS u32x4*)(Qs + i * LQ + part * 8) = w;
              u32x4 w2; w2.x = pk2(o2[0], o2[1]); w2.y = pk2(o2[2], o2[3]); w2.z = pk2(o2[4], o2[5]); w2.w = pk2(o2[6], o2[7]); *(LAS u32x4*)(Qs + i * LQ + 32 + part * 8) = w2; }
#pragma unroll
            for (int q = 0; q < 4; ++q) { const unsigned vw[4] = {pv[q].x, pv[q].y, pv[q].z, pv[q].w};
#pragma unroll
                for (int e = 0; e < 8; ++e) { const int vrow = (2 * part + (e >> 2)) * 16 + 4 * q + (e & 3);
                    VTs[vrow * LT + i] = (unsigned short)((e & 1) ? (vw[e >> 1] >> 16) : (vw[e >> 1] & 0xffffu)); } }
        }
        if (ch + 1 < 18) prefetch(ch + 1);
        __syncthreads();
        f32x4 oacc[8];
        if (!isctx) {
            f32x4 sacc[8];
#pragma unroll
            for (int nb = 0; nb < 8; ++nb) { sacc[nb] = (f32x4){0.f, 0.f, 0.f, 0.f}; oacc[nb] = (f32x4){0.f, 0.f, 0.f, 0.f}; }
            wave_mma<8, 2>(Qs + wave * 16 * LQ, LQ, Ks, LQ, sacc, fr, fq);
            wave_mma<8, 2>(Qs + wave * 16 * LQ, LQ, RTs, LQ, oacc, fr, fq);
            const int qi = wave * 16 + fr; const float qd = __expf(lg * (float)(qi + 1));
#pragma unroll
            for (int nb = 0; nb < 8; ++nb) { oacc[nb].x *= qd; oacc[nb].y *= qd; oacc[nb].z *= qd; oacc[nb].w *= qd; }
            __syncthreads();
#pragma unroll
            for (int nb = 0; nb < 8; ++nb) { float sv[4] = {sacc[nb].x, sacc[nb].y, sacc[nb].z, sacc[nb].w};
#pragma unroll
                for (int e = 0; e < 4; ++e) { const int jj = nb * 16 + fq * 4 + e; const int df = qi - jj; const bool keep = dir ? (df > 0) : (df >= 0);
                    sv[e] = keep ? sv[e] * __expf(lg * (float)df) : 0.f; }
                u32x2 w; w.x = pk2(sv[0], sv[1]); w.y = pk2(sv[2], sv[3]); *(LAS u32x2*)(Ss + qi * LT + nb * 16 + fq * 4) = w; }
            __syncthreads();
            wave_mma<8, 4>(Ss + wave * 16 * LT, LT, VTs, LT, oacc, fr, fq);
            { const int pos = n * 128 + qi; const int t = dir ? (L - 1 - pos) : pos; bf16_t* dst = Yd + (size_t)(base + t) * 768 + h * 128;
#pragma unroll
              for (int j = 0; j < 4; ++j) { u32x4 w; w.x = pk2(oacc[2 * j].x, oacc[2 * j].y); w.y = pk2(oacc[2 * j].z, oacc[2 * j].w); w.z = pk2(oacc[2 * j + 1].x, oacc[2 * j + 1].y); w.w = pk2(oacc[2 * j + 1].z, oacc[2 * j + 1].w);
                  __builtin_nontemporal_store(w, (u32x4*)(dst + 32 * j + 8 * fq)); } }
        }
#pragma unroll
        for (int nb = 0; nb < 4; ++nb) { racc[nb].x *= cdec; racc[nb].y *= cdec; racc[nb].z *= cdec; racc[nb].w *= cdec; }
        wave_mma<4, 4>(VTs + wave * 16 * LT, LT, KTs, LT, racc, fr, fq);
        __syncthreads();
#pragma unroll
        for (int nb = 0; nb < 4; ++nb) { u32x2 w; w.x = pk2(racc[nb].x, racc[nb].y); w.y = pk2(racc[nb].z, racc[nb].w); *(LAS u32x2*)(RTs + (wave * 16 + fr) * LQ + nb * 16 + fq * 4) = w; }
    }
}

__device__ __forceinline__ void conv_item(const Params& p, LAS unsigned char* lds, int item) {
    const int tid = tidx(), lane = tid & 63, wave = tid >> 6;
    const int b = item >> 6, t0 = (item & 63) * 32;
    const bf16_t* P = (const bf16_t*)(p.ws + WS_P); bf16_t* MX = (bf16_t*)(p.ws + WS_HM);
    LAS float* Hs = (LAS float*)lds;
    LAS float* Cs = Hs + 62 * 256;
    __syncthreads();
    for (int i = tid; i < 62 * 32; i += NT) { const int rr = i >> 5, c8 = (i & 31) * 8; const int t = t0 - 15 + rr; float hv[8];
#pragma unroll
        for (int e = 0; e < 8; ++e) hv[e] = 0.f;
        if (t >= 0 && t < 2048) { const size_t ro = (size_t)(b * 2048 + t) * PW + 2304; const u32x4 a = *(const u32x4*)(P + ro + c8), g = *(const u32x4*)(P + ro + 256 + c8);
            const unsigned aw[4] = {a.x, a.y, a.z, a.w}, gw[4] = {g.x, g.y, g.z, g.w};
#pragma unroll
            for (int e = 0; e < 4; ++e) { hv[2 * e] = bflo(aw[e]) * sigmoidf_(bflo(gw[e])); hv[2 * e + 1] = bfhi(aw[e]) * sigmoidf_(bfhi(gw[e])); } }
        *(LAS f32x4*)(Hs + rr * 256 + c8) = (f32x4){hv[0], hv[1], hv[2], hv[3]}; *(LAS f32x4*)(Hs + rr * 256 + c8 + 4) = (f32x4){hv[4], hv[5], hv[6], hv[7]}; }
    __syncthreads();
    { const int c = tid & 255, th = tid >> 8; float w[31], hwin[46];
#pragma unroll
      for (int j = 0; j < 31; ++j) w[j] = p.in[I_CONVW][j * 256 + c];
      const float cb = p.in[I_CONVB][c];
#pragma unroll
      for (int r = 0; r < 46; ++r) hwin[r] = Hs[(th * 16 + r) * 256 + c];
#pragma unroll
      for (int tt = 0; tt < 16; ++tt) { float s0 = cb, s1 = 0.f;
#pragma unroll
          for (int j = 0; j < 30; j += 2) { s0 += hwin[tt + j] * w[j]; s1 += hwin[tt + j + 1] * w[j + 1]; }
          s0 += hwin[tt + 30] * w[30];
          Cs[(th * 16 + tt) * 256 + c] = s0 + s1; } }
    __syncthreads();
    for (int tt = 0; tt < 4; ++tt) { const int t = wave * 4 + tt; const f32x4 v = *(const LAS f32x4*)(Cs + t * 256 + lane * 4);
        const float mu = wave_sum((v.x + v.y) + (v.z + v.w)) * (1.f / 256.f);
        const float d0 = v.x - mu, d1 = v.y - mu, d2 = v.z - mu, d3 = v.w - mu;
        const float rs = rsqrtf(wave_sum(d0 * d0 + d1 * d1 + d2 * d2 + d3 * d3) * (1.f / 256.f) + 1e-5f);
        const f32x4 g = *(const f32x4*)(p.in[I_LNG] + lane * 4), bb = *(const f32x4*)(p.in[I_LNB] + lane * 4);
        u32x2 w; w.x = pk2(siluf_(d0 * rs * g.x + bb.x), siluf_(d1 * rs * g.y + bb.y)); w.y = pk2(siluf_(d2 * rs * g.z + bb.z), siluf_(d3 * rs * g.w + bb.w));
        *(u32x2*)(MX + (size_t)(b * 2048 + t0 + t) * 1024 + 768 + lane * 4) = w; }
}
__device__ __forceinline__ void phase_ret_conv(const Params& p, LAS unsigned char* lds) {
    const int bid = blockIdx.x, G = gridDim.x;
    if (G >= 256) {
        if (bid < 192) retention_unit(p, lds, bid);
        else { for (int it = bid - 192; it < 1024; it += G - 192) conv_item(p, lds, it);
 }
    } else {
        for (int u = bid; u < 192; u += G) retention_unit(p, lds, u);
        for (int it = bid; it < 1024; it += G) conv_item(p, lds, it);
    }
}
__device__ __forceinline__ void phase_ret_out(const Params& p) {
    const int lane = tidx() & 63, gw = blockIdx.x * 8 + (tidx() >> 6), GW = gridDim.x * 8;
    const bf16_t* P = (const bf16_t*)(p.ws + WS_P); const bf16_t* YF = (const bf16_t*)(p.ws + WS_YRF); const bf16_t* YB = (const bf16_t*)(p.ws + WS_YRB); bf16_t* MX = (bf16_t*)(p.ws + WS_HM);
    for (int row0 = gw * 2; row0 < XR; row0 += GW * 2) {
#pragma unroll
        for (int ps = 0; ps < 3; ++ps) {
            const int s = ps * 64 + lane, rsel = s >= 96 ? 1 : 0, ch = (s - rsel * 96) * 8; const int row = row0 + rsel;
            const u32x4 yf = __builtin_nontemporal_load((const u32x4*)(YF + (size_t)row * 768 + ch)), yb = __builtin_nontemporal_load((const u32x4*)(YB + (size_t)row * 768 + ch)), gg = *(const u32x4*)(P + (size_t)row * PW + 1536 + ch);
            const unsigned yfw[4] = {yf.x, yf.y, yf.z, yf.w}, ybw[4] = {yb.x, yb.y, yb.z, yb.w}, ggw[4] = {gg.x, gg.y, gg.z, gg.w};
            float y[8]; float sm = 0.f;
#pragma unroll
            for (int e = 0; e < 4; ++e) { y[2 * e] = bflo(yfw[e]) + bflo(ybw[e]); y[2 * e + 1] = bfhi(yfw[e]) + bfhi(ybw[e]); sm += y[2 * e] + y[2 * e + 1]; }
            sm = red8(sm); sm += dppf<0x140>(sm);
            const float mu = sm * (1.f / 128.f); float q = 0.f;
#pragma unroll
            for (int e = 0; e < 8; ++e) { y[e] -= mu; q += y[e] * y[e]; }
            q = red8(q); q += dppf<0x140>(q);
            const float rs = rsqrtf(q * (1.f / 128.f) + 1e-5f);
            const f32x4 c0 = *(const f32x4*)(p.in[I_GNG] + ch), c1 = *(const f32x4*)(p.in[I_GNG] + ch + 4), d0 = *(const f32x4*)(p.in[I_GNB] + ch), d1 = *(const f32x4*)(p.in[I_GNB] + ch + 4);
            const float lg[8] = {c0.x, c0.y, c0.z, c0.w, c1.x, c1.y, c1.z, c1.w}, lb[8] = {d0.x, d0.y, d0.z, d0.w, d1.x, d1.y, d1.z, d1.w};
            float o8[8];
#pragma unroll
            for (int e = 0; e < 8; ++e) { const unsigned wg = ggw[e >> 1]; const float g1 = (e & 1) ? bfhi(wg) : bflo(wg); o8[e] = (y[e] * rs * lg[e] + lb[e]) * siluf_(g1); }
            u32x4 w; w.x = pk2(o8[0], o8[1]); w.y = pk2(o8[2], o8[3]); w.z = pk2(o8[4], o8[5]); w.w = pk2(o8[6], o8[7]);
            *(u32x4*)(MX + (size_t)row * 1024 + ch) = w;
        }
    }
}

__global__ void __launch_bounds__(512) hybrid_fwd(Params p) {
    extern __shared__ __attribute__((aligned(16))) unsigned char shm[];
    LAS unsigned char* lds = (LAS unsigned char*)shm;
    cg::grid_group grid = cg::this_grid();
    unsigned char* ws = p.ws;
    bf16_t* HM = (bf16_t*)(ws + WS_HM); bf16_t* PB = (bf16_t*)(ws + WS_P);
    const float* MODX = (const float*)(ws + WS_MODX); const float* MODC = (const float*)(ws + WS_MODC); float* CON = (float*)(ws + WS_CON);
    { volatile LAS unsigned* st0 = (volatile LAS unsigned*)(lds + (LDS_BYTES - 16)); if (tidx() < 4) st0[tidx()] = 0u; __syncthreads(); }
    const XcdBarrier xb = xcd_barrier_post((unsigned*)(ws + WS_BAR), (volatile LAS unsigned*)(lds + (LDS_BYTES - 16)));
    prep_mods(p, lds, blockIdx.x, gridDim.x);
    prep_transposes(p, lds, 6112, 6136, blockIdx.x, gridDim.x);
    prep_transposes(p, lds, 0, PREP_T_ABIN, blockIdx.x, gridDim.x);
    prep_fold_tables(p, lds, blockIdx.x, gridDim.x);
    xcd_barrier(xb);
    if (p.ws == nullptr) grid.sync();
    int vc;
    { volatile LAS unsigned* st0 = (volatile LAS unsigned*)(lds + (LDS_BYTES - 16));
      if (tidx() == 0) { const unsigned G = gridDim.x; bool ok = (G % 8u) == 0u; unsigned* bar = (unsigned*)(ws + WS_BAR);
          for (unsigned j = 0; j < 16; ++j) { const unsigned c = xb_ld(&bar[XB_XCNT(j)]); ok = ok && (j < 8 ? c == G / 8u : c == 0u); }
          st0[3] = ok ? (st0[2] * 8u + xb.x) : (unsigned)blockIdx.x; }
      __syncthreads(); vc = (int)st0[3]; }
    phase_modnorm(p, p.in[I_X], p.in[I_CTX], p.in[I_NMIXG], 0, 0, TOK);
    xcd_barrier(xb);
    { EpiAbIn E; E.P = PB; E.VTX = (bf16_t*)(ws + WS_VTX); E.VTC = (bf16_t*)(ws + WS_VTC);
      run_gemm(lds, HM, (const bf16_t*)(ws + WS_WABIN), TOK, NABIN, 1024, E, vc); }
    xcd_barrier(xb);
    phase_scan(p, lds);
    xcd_barrier(xb);
    phase_rwkv_out(p);
    phase_swc(p);
    xcd_barrier(xb);
    const int GG_ = gridDim.x, NC = GG_ >= 256 ? 64 : (GG_ >= 8 ? GG_ / 4 : 1), NX = GG_ - NC; const bool cwg = (int)blockIdx.x >= NX;
    float* SS = (float*)(ws + WS_SS); const float* SWC = (const float*)(ws + WS_SWC); bf16_t* HS = (bf16_t*)(ws + WS_SCR);
    { EpiResid E; E.basex = p.in[I_X]; E.basec = p.in[I_CTX]; E.outx = p.out; E.outc = CON; E.gatex = MODX + 2 * 1024; E.gatec = MODC + 2 * 1024;
      run_gemm(lds, HM, (const bf16_t*)(ws + WS_WABOUT), XR, 1024, 1024, E, vc); }
    xcd_barrier(xb);
    if (cwg) { EpiResidH E; E.base = p.in[I_CTX]; E.out = CON; E.gate = MODC + 2 * 1024; E.g = p.in[I_NFFNG]; E.scale = MODC + 4 * 1024; E.Hn = HS; E.SS = SS;
        run_gemm_ctx(lds, HM, (const bf16_t*)(ws + WS_WABOUT), 1024, 1024, E, NC, (int)blockIdx.x - NX); }
    else phase_modnorm(p, p.out, CON, p.in[I_NFFNG], 0, 3, XR, blockIdx.x, NX);
    xcd_barrier(xb);
    { EpiSwiglu E; E.Gh = PB; run_gemm(lds, HM, (const bf16_t*)(ws + WS_W13), XR, 5632, 1024, E, vc); }
    { EpiSwigluCtx E; E.Gh = PB; E.SS = SS; E.SW = SWC; run_gemm_ctx(lds, HS, (const bf16_t*)(ws + WS_W13), 5632, 1024, E, GG_, vc); }
    xcd_barrier(xb);
    { EpiResid E; E.basex = p.out; E.basec = CON; E.outx = p.out; E.outc = CON; E.gatex = MODX + 5 * 1024; E.gatec = MODC + 5 * 1024;
      run_gemm(lds, PB, (const bf16_t*)(ws + WS_W2), XR, 1024, 2816, E, vc); }
    xcd_barrier(xb);
    if (cwg) { EpiResidH E; E.base = CON; E.out = CON; E.gate = MODC + 5 * 1024; E.g = p.in[I_NMIXG] + 1024; E.scale = MODC + 6144 + 1 * 1024; E.Hn = HM; E.SS = SS + TOK;
        run_gemm_ctx(lds, PB, (const bf16_t*)(ws + WS_W2), 1024, 2816, E, NC, (int)blockIdx.x - NX); }
    else phase_modnorm(p, p.out, CON, p.in[I_NMIXG] + 1024, 1, 0, XR, blockIdx.x, NX);
    xcd_barrier(xb);
    { EpiCdIn E; E.O = PB; E.SS = SS + TOK; E.SW = SWC + 5632; run_gemm_cdin(lds, HM, (const bf16_t*)(ws + WS_WCDIN), E, vc); }
    xcd_barrier(xb);
    phase_ret_conv(p, lds);
    xcd_barrier(xb);
    phase_ret_out(p);
    xcd_barrier(xb);
    { EpiResid E; E.basex = p.out; E.basec = CON; E.outx = p.out; E.outc = CON; E.gatex = MODX + 16 * 6144 + 2 * 1024; E.gatec = MODC + 6144 + 2 * 1024;
      run_gemm(lds, HM, (const bf16_t*)(ws + WS_WCDOUT), XR, 1024, 1024, E, vc); }
    xcd_barrier(xb);
    phase_modnorm(p, p.out, CON, p.in[I_NFFNG] + 1024, 1, 3, XR);
    xcd_barrier(xb);
    { EpiSwiglu E; E.Gh = PB; run_gemm(lds, HM, (const bf16_t*)(ws + WS_W13) + (size_t)5632 * 1024, XR, 5632, 1024, E, vc); }
    xcd_barrier(xb);
    { EpiResid E; E.basex = p.out; E.basec = CON; E.outx = p.out; E.outc = CON; E.gatex = MODX + 16 * 6144 + 5 * 1024; E.gatec = MODC + 6144 + 5 * 1024;
      run_gemm(lds, PB, (const bf16_t*)(ws + WS_W2) + (size_t)1024 * 2816, XR, 1024, 2816, E, vc); }
    xcd_barrier(xb);
    phase_final_norm(p);
}

extern "C" void kernel_launch(void* const* d_in, const int* in_sizes, int n_in, void* d_out, int out_size, void* d_ws, size_t ws_size, hipStream_t stream) {
    static int grid_blocks = 0;
    if (grid_blocks == 0) {
        if (n_in != 35 || in_sizes[0] != XR * D || out_size != XR * D || ws_size < WS_END) { fprintf(stderr, "kernel_launch: unexpected shapes (n_in %d, in0 %d, out %d, ws %zu need %zu)\n", n_in, n_in > 0 ? in_sizes[0] : -1, out_size, ws_size, (size_t)WS_END); grid_blocks = -1; return; }
        int dev = 0, cus = 0, per_cu = 0;
        hipGetDevice(&dev); hipDeviceGetAttribute(&cus, hipDeviceAttributeMultiprocessorCount, dev);
        if (hipFuncSetAttribute((const void*)hybrid_fwd, hipFuncAttributeMaxDynamicSharedMemorySize, LDS_BYTES) != hipSuccess) { fprintf(stderr, "hipFuncSetAttribute failed\n"); grid_blocks = -1; return; }
        if (hipOccupancyMaxActiveBlocksPerMultiprocessor(&per_cu, (const void*)hybrid_fwd, NT, LDS_BYTES) != hipSuccess || per_cu < 1) { fprintf(stderr, "occupancy query failed (%d)\n", per_cu); (void)hipGetLastError(); per_cu = 1; }
        grid_blocks = cus * per_cu;
        fprintf(stderr, "kernel_launch: grid %d (cus %d x %d)\n", grid_blocks, cus, per_cu);
    }
    if (grid_blocks < 0) return;
    if (hipMemsetAsync((unsigned char*)d_ws + WS_BAR, 0, 16384, stream) != hipSuccess) { fprintf(stderr, "memset failed\n"); return; }
    Params p{};
    for (int i = 0; i < 35; ++i) p.in[i] = (const float*)d_in[i];
    p.out = (float*)d_out; p.ws = (unsigned char*)d_ws;
    void* args[] = {&p};
    hipError_t e = hipLaunchCooperativeKernel((const void*)hybrid_fwd, dim3(grid_blocks), dim3(NT), args, LDS_BYTES, stream);
    if (e != hipSuccess) fprintf(stderr, "cooperative launch failed: %s (grid %d)\n", hipGetErrorString(e), grid_blocks);
}
```

```cpp
#include <hip/hip_runtime.h>
#include <hip/hip_cooperative_groups.h>
#include <cstdio>
#include <cstdint>
namespace cg = cooperative_groups;
namespace pg8 {
#define PG8_LAS __attribute__((address_space(3)))
typedef unsigned short bf16_t;
typedef short bf16x8 __attribute__((ext_vector_type(8)));
typedef float f32x4 __attribute__((ext_vector_type(4)));
typedef unsigned u32x4 __attribute__((ext_vector_type(4)));
constexpr int BM = 256, BK = 64, HALF = 128, HTB = HALF * BK * 2  , STAGE_BYTES = 8 * HTB, NXCD = 8, WGM = 8;

__host__ __device__ __forceinline__ int lds_byte(int r, int c) { const int st = (r >> 4) * 2 + (c >> 5), rr = r & 15, cc = c & 31, ob = rr * 64 + cc * 2; return st * 1024 + (ob ^ (((ob >> 9) & 1) << 5)); }
__host__ __device__ __forceinline__ void stage_rc(int b, int& R, int& C) { const int st = b / 1024, sb = b % 1024, swz = sb ^ (((sb >> 9) & 1) << 5); R = (st >> 1) * 16 + swz / 64; C = (st & 1) * 32 + (swz % 64) / 2; }
__host__ __device__ __forceinline__ int perm32(int rho) { const int n = rho >> 4, i = rho & 15; return 8 * (i >> 2) + 4 * n + (i & 3); }

struct Unit { int pm, pn; };
struct Gemm { const bf16_t* A; const bf16_t* Bt; int M, N, K; };

struct StaticOrder {
    int nM, nN, nwg, G, c;
    __host__ __device__ void init(int M, int N, int G_, int c_) { nM = M / BM; nN = N / BM; nwg = nM * nN; G = G_; c = c_; }
    __host__ __device__ bool next(int i, Unit& u) const {
        const long L = (long)i * G + c; if (L >= nwg) return false;
        int wgid = (int)L; { const int q = nwg / NXCD, r = nwg % NXCD, xcd = wgid % NXCD, off = wgid / NXCD; wgid = (xcd < r ? xcd * (q + 1) : r * (q + 1) + (xcd - r) * q) + off; }
        const int nig = WGM * nN, gid = wgid / nig, fm = gid * WGM, gsz = (nM - fm) < WGM ? (nM - fm) : WGM;
        u.pm = fm + ((wgid % nig) % gsz); u.pn = (wgid % nig) / gsz; return true;
    }
    __device__ __forceinline__ void a_ready(const Unit&) const {}
    __device__ __forceinline__ void done(const Unit&) const {}
};
__device__ __forceinline__ unsigned cvt_pk_bf16(float lo, float hi) { unsigned r; asm volatile("v_cvt_pk_bf16_f32 %0, %1, %2" : "=v"(r) : "v"(lo), "v"(hi)); return r; }
typedef float f32x2 __attribute__((ext_vector_type(2)));
template <class Epi, class Sched, bool ALIGN_EPI = false, bool SP2 = false>
__device__ __forceinline__ void gemm_phase(PG8_LAS unsigned char* lds, const Gemm g, const Sched& S, const Epi& E) {
    int tid_ = threadIdx.x; asm volatile("" : "+v"(tid_));
    const int tid = tid_, wid = __builtin_amdgcn_readfirstlane(tid >> 6), lane = tid & 63, wr = wid >> 2, wc = wid & 3, fr = lane & 15, fq = lane >> 4;
    const int K = g.K, nt = K / BK;
    unsigned voffA[2], voffB[2];
#pragma unroll
    for (int i = 0; i < 2; ++i) { int R, C; stage_rc(tid * 16 + i * 8192, R, C); const int Rb = Epi::PERM ? ((R & ~31) + perm32(R & 31)) : R;
        voffA[i] = (unsigned)(R * K + C) * 2u; voffB[i] = (unsigned)(Rb * K + C) * 2u; }
    const size_t kstep = (size_t)(BK * 2);
    const size_t hstep = (size_t)HALF * K * 2;
    const size_t tstep = 2 * hstep;
    const unsigned ldsw = (unsigned)wid * 1024u;
    const int aoff = lds_byte(wr * 64 + fr, fq * 8), boff = lds_byte(wc * 32 + fr, fq * 8);
#define PG8_SA(b, h) (((b) * 2 + (h)) * HTB)
#define PG8_SB(b, h) ((4 + (b) * 2 + (h)) * HTB)
#define PG8_STAGE(bufoff, gbase, voff) do { _Pragma("unroll") for (int _i = 0; _i < 2; ++_i) \
        __builtin_amdgcn_global_load_lds((const unsigned*)((const char*)(gbase) + (voff)[_i]), (PG8_LAS unsigned*)(lds + (bufoff) + ldsw + _i * 8192), 16, 0, 0); } while (0)
#define PG8_LDA(dst, b, h) do { _Pragma("unroll") for (int m = 0; m < 4; ++m) _Pragma("unroll") for (int k = 0; k < 2; ++k) dst[m][k] = *(const PG8_LAS bf16x8*)(lds + PG8_SA(b, h) + aoff + m * 2048 + k * 1024); } while (0)
#define PG8_LDB(dst, b, h) do { _Pragma("unroll") for (int n = 0; n < 2; ++n) _Pragma("unroll") for (int k = 0; k < 2; ++k) dst[n][k] = *(const PG8_LAS bf16x8*)(lds + PG8_SB(b, h) + boff + n * 2048 + k * 1024); } while (0)
#define PG8_MMA(ai, bj, At, Bt) do { __builtin_amdgcn_s_setprio(1); _Pragma("unroll") for (int m = 0; m < 4; ++m) _Pragma("unroll") for (int n = 0; n < 2; ++n) _Pragma("unroll") for (int k = 0; k < 2; ++k) \
        acc[ai][bj][m][n] = __builtin_amdgcn_mfma_f32_16x16x32_bf16(Bt[n][k], At[m][k], acc[ai][bj][m][n], 0, 0, 0); __builtin_amdgcn_s_setprio(0); } while (0)
#define PG8_WAIT_V(n) asm volatile("s_waitcnt vmcnt(" #n ")" ::: "memory")
#define PG8_WAIT_L(n) asm volatile("s_waitcnt lgkmcnt(" #n ")" ::: "memory")
#define PG8_BAR __builtin_amdgcn_s_barrier()
#define PG8_SCHED __builtin_amdgcn_sched_barrier(0)
    Unit cur, nxt; int ui = 0;
    if (!S.next(0, cur)) return;
    f32x4 acc[2][2][4][2];
#pragma unroll
    for (int a = 0; a < 2; ++a)
#pragma unroll
        for (int b = 0; b < 2; ++b)
#pragma unroll
            for (int m = 0; m < 4; ++m)
#pragma unroll
                for (int n = 0; n < 2; ++n) acc[a][b][m][n] = (f32x4){0.f, 0.f, 0.f, 0.f};
    bf16x8 At[4][2], B0[2][2], B1[2][2];
    const char* cA = (const char*)g.A + (size_t)cur.pm * tstep; const char* cB = (const char*)g.Bt + (size_t)cur.pn * tstep;
    S.a_ready(cur);
    if constexpr (SP2) {
        PG8_STAGE(PG8_SB(0, 0), cB, voffB); PG8_STAGE(PG8_SB(0, 1), cB + hstep, voffB); PG8_STAGE(PG8_SA(0, 0), cA, voffA); PG8_STAGE(PG8_SA(0, 1), cA + hstep, voffA);
        if (wr == 1) PG8_BAR;
        PG8_WAIT_V(2); PG8_BAR;
        PG8_STAGE(PG8_SB(1, 0), cB + kstep, voffB); PG8_STAGE(PG8_SA(1, 0), cA + kstep, voffA); PG8_STAGE(PG8_SB(1, 1), cB + hstep + kstep, voffB);
        PG8_WAIT_V(6); PG8_BAR;
    } else {
        PG8_STAGE(PG8_SB(0, 0), cB, voffB); PG8_STAGE(PG8_SA(0, 0), cA, voffA); PG8_STAGE(PG8_SB(0, 1), cB + hstep, voffB); PG8_STAGE(PG8_SA(0, 1), cA + hstep, voffA);
        if (wr == 1) PG8_BAR;
        PG8_WAIT_V(4); PG8_BAR;
        PG8_STAGE(PG8_SB(1, 0), cB + kstep, voffB); PG8_STAGE(PG8_SA(1, 0), cA + kstep, voffA); PG8_STAGE(PG8_SB(1, 1), cB + hstep + kstep, voffB);
        PG8_WAIT_V(6); PG8_BAR;
    }
    for (;;) {
        const bool has_next = S.next(ui + 1, nxt);
        const char* nA = has_next ? (const char*)g.A + (size_t)nxt.pm * tstep : cA; const char* nB = has_next ? (const char*)g.Bt + (size_t)nxt.pn * tstep : cB;
        for (int t = 0; t < nt; t += 2) {
            const bool last = (t == nt - 2);
            const char* a1 = cA + (size_t)(t + 1) * kstep;
            const char* a2 = last ? nA : cA + (size_t)(t + 2) * kstep; const char* b2 = last ? nB : cB + (size_t)(t + 2) * kstep;
            const char* a3 = a2 + kstep; const char* b3 = b2 + kstep;
            if (last && has_next) S.a_ready(nxt);
            if constexpr (SP2) {
            PG8_LDB(B0, 0, 0); PG8_LDB(B1, 0, 1); PG8_SCHED; PG8_LDA(At, 0, 0); PG8_STAGE(PG8_SA(1, 1), a1 + hstep, voffA);
            PG8_WAIT_V(8); PG8_WAIT_L(0); PG8_BAR; PG8_MMA(0, 0, At, B0); PG8_MMA(0, 1, At, B1); PG8_BAR; PG8_SCHED;
            PG8_LDA(At, 0, 1); PG8_STAGE(PG8_SB(0, 0), b2, voffB); PG8_STAGE(PG8_SB(0, 1), b2 + hstep, voffB); PG8_STAGE(PG8_SA(0, 0), a2, voffA);
            PG8_WAIT_V(8); PG8_WAIT_L(0); PG8_BAR; PG8_MMA(1, 0, At, B0); PG8_MMA(1, 1, At, B1); PG8_BAR; PG8_SCHED;
            PG8_LDB(B0, 1, 0); PG8_LDB(B1, 1, 1); PG8_SCHED; PG8_LDA(At, 1, 0); PG8_STAGE(PG8_SA(0, 1), a2 + hstep, voffA);
            PG8_WAIT_V(8); PG8_WAIT_L(0); PG8_BAR; PG8_MMA(0, 0, At, B0); PG8_MMA(0, 1, At, B1); PG8_BAR; PG8_SCHED;
            PG8_LDA(At, 1, 1); PG8_STAGE(PG8_SB(1, 0), b3, voffB); PG8_STAGE(PG8_SB(1, 1), b3 + hstep, voffB); PG8_STAGE(PG8_SA(1, 0), a3, voffA);
            PG8_WAIT_V(8); PG8_WAIT_L(0); PG8_BAR; PG8_MMA(1, 0, At, B0); PG8_MMA(1, 1, At, B1); PG8_BAR; PG8_SCHED;
            } else {
            PG8_LDB(B0, 0, 0); PG8_SCHED; PG8_LDA(At, 0, 0); PG8_STAGE(PG8_SA(1, 1), a1 + hstep, voffA);
            PG8_WAIT_L(8); PG8_BAR; PG8_WAIT_L(0); PG8_MMA(0, 0, At, B0); PG8_BAR; PG8_SCHED;
            PG8_LDB(B1, 0, 1); PG8_STAGE(PG8_SB(0, 0), b2, voffB);
            PG8_BAR; PG8_WAIT_L(0); PG8_MMA(0, 1, At, B1); PG8_BAR;
            PG8_LDA(At, 0, 1); PG8_STAGE(PG8_SA(0, 0), a2, voffA);
            PG8_BAR; PG8_WAIT_L(0); PG8_MMA(1, 0, At, B0); PG8_BAR; PG8_SCHED;
            PG8_STAGE(PG8_SB(0, 1), b2 + hstep, voffB);
            PG8_WAIT_V(6); PG8_BAR; PG8_MMA(1, 1, At, B1); PG8_BAR;
            PG8_LDB(B0, 1, 0); PG8_SCHED; PG8_LDA(At, 1, 0); PG8_STAGE(PG8_SA(0, 1), a2 + hstep, voffA);
            PG8_WAIT_L(8); PG8_BAR; PG8_WAIT_L(0); PG8_MMA(0, 0, At, B0); PG8_BAR; PG8_SCHED;
            PG8_LDB(B1, 1, 1); PG8_STAGE(PG8_SB(1, 0), b3, voffB);
            PG8_BAR; PG8_WAIT_L(0); PG8_MMA(0, 1, At, B1); PG8_BAR;
            PG8_LDA(At, 1, 1); PG8_STAGE(PG8_SA(1, 0), a3, voffA);
            PG8_BAR; PG8_WAIT_L(0); PG8_MMA(1, 0, At, B0); PG8_BAR; PG8_SCHED;
            PG8_STAGE(PG8_SB(1, 1), b3 + hstep, voffB);
            PG8_WAIT_V(6); PG8_BAR; PG8_MMA(1, 1, At, B1); PG8_BAR;
            }
        }
        if constexpr (ALIGN_EPI) { if (wr == 0) PG8_BAR; }
        if constexpr (!Epi::AFTER_DRAIN) { E(acc, cur, wr, wc, fr, fq); S.done(cur); }
        if (!has_next) break;
#pragma unroll
        for (int a = 0; a < 2; ++a)
#pragma unroll
            for (int b = 0; b < 2; ++b)
#pragma unroll
                for (int m = 0; m < 4; ++m)
#pragma unroll
                    for (int n = 0; n < 2; ++n) acc[a][b][m][n] = (f32x4){0.f, 0.f, 0.f, 0.f};
        cur = nxt; cA = nA; cB = nB; ++ui;
        if constexpr (ALIGN_EPI) { if (wr == 1) PG8_BAR; }
    }
    PG8_WAIT_V(0);
    if constexpr (!ALIGN_EPI) { if (wr == 0) PG8_BAR; }
    PG8_BAR;
    if constexpr (Epi::AFTER_DRAIN) { E.fused(acc, cur, wr, wc, fr, fq, lds, wid, lane); S.done(cur); }
#undef PG8_SA
#undef PG8_SB
#undef PG8_STAGE
#undef PG8_LDA
#undef PG8_LDB
#undef PG8_MMA
#undef PG8_WAIT_V
#undef PG8_WAIT_L
#undef PG8_BAR
#undef PG8_SCHED
}
}
#define LAS __attribute__((address_space(3)))
typedef unsigned short bf16_t;
using pg8::bf16x8; using pg8::f32x4; using pg8::cvt_pk_bf16;
typedef unsigned u32x2 __attribute__((ext_vector_type(2)));
typedef unsigned u32x4 __attribute__((ext_vector_type(4)));

constexpr int D = 1024, NBAT = 16, SEQ = 2048, CTX = 256, XR = NBAT * SEQ, CR = NBAT * CTX, TOK = XR + CR;
constexpr int PW = 2816, FF = 2816, NABIN = 3328, RW = 768;
constexpr int NT = 512;
constexpr int LDS_BYTES = 147456;

constexpr size_t WS_WABIN = 0;
constexpr size_t WS_WABOUT = WS_WABIN + (size_t)NABIN * 1024 * 2;
constexpr size_t WS_WCDIN = WS_WABOUT + (size_t)1024 * 1024 * 2;
constexpr size_t WS_WCDOUT = WS_WCDIN + (size_t)2816 * 1024 * 2;
constexpr size_t WS_W13 = WS_WCDOUT + (size_t)1024 * 1024 * 2;
constexpr size_t WS_W2 = WS_W13 + (size_t)2 * 5632 * 1024 * 2;
constexpr size_t WS_G2 = WS_W2 + (size_t)2 * 1024 * 2816 * 2;
constexpr size_t WS_TX = WS_G2 + (size_t)768 * 256 * 2;
constexpr size_t WS_TC = WS_TX + (size_t)2048 * 4096 * 2;
constexpr size_t WS_ROPE = WS_TC + (size_t)256 * 512 * 2;
constexpr size_t WS_MODX = WS_ROPE + (size_t)2048 * 64 * 4;
constexpr size_t WS_MODC = WS_MODX + (size_t)2 * 16 * 6144 * 4;
constexpr size_t WS_BONUS = WS_MODC + (size_t)2 * 6144 * 4;
constexpr size_t WS_CON = WS_BONUS + (size_t)TOK * 12 * 4;
constexpr size_t WS_HM = WS_CON + (size_t)CR * 1024 * 4;
constexpr size_t WS_P = WS_HM + (size_t)TOK * 1024 * 2;
constexpr size_t WS_SCR = WS_P + (size_t)TOK * PW * 2;
constexpr size_t WS_VTX = WS_SCR;
constexpr size_t WS_VTC = WS_VTX + (size_t)4096 * 4096 * 2;
constexpr size_t WS_GG = WS_VTC + (size_t)4096 * 512 * 2;
constexpr size_t WS_YRF = WS_SCR;
constexpr size_t WS_YRB = WS_SCR + (size_t)XR * 768 * 2;
constexpr size_t WS_BAR = WS_SCR + (size_t)100663296;
constexpr size_t WS_SS = WS_BAR + 16384;
constexpr size_t WS_SWC = WS_SS + (size_t)2 * TOK * 4;
constexpr size_t WS_END = WS_SWC + (size_t)(5632 + 2816) * 4;
constexpr size_t DO_YF = 0, DO_YB = (size_t)TOK * 768 * 2, DO_SGL = (size_t)2 * TOK * 768 * 2;

__device__ __forceinline__ int tidx() { int t = threadIdx.x; asm volatile("" : "+v"(t)); return t; }
struct Params { const float* in[35]; float* out; unsigned char* ws; };
enum { I_X = 0, I_C, I_CTX, I_CCTX, I_ADAW, I_ADAB, I_NMIXG, I_NFFNG, I_ABWIN, I_MUP, I_MUN, I_W0, I_W2, I_A0, I_A2, I_G2, I_KK, I_KA, I_RK, I_LNXG, I_LNXB, I_ABWOUT,
       I_CDWIN, I_DECAYP, I_GNG, I_GNB, I_CONVW, I_CONVB, I_LNG, I_LNB, I_CDWOUT, I_W1, I_W3, I_FW2, I_FINALG };

typedef __bf16 bf2_t __attribute__((ext_vector_type(2)));
__device__ __forceinline__ unsigned short f2bf(float f) { return __builtin_bit_cast(unsigned short, (__bf16)f); }
__device__ __forceinline__ float bf2f(unsigned short b) { return __uint_as_float(((unsigned)b) << 16); }
__device__ __forceinline__ float bflo(unsigned w) { return __uint_as_float(w << 16); }
__device__ __forceinline__ float bfhi(unsigned w) { return __uint_as_float(w & 0xffff0000u); }
__device__ __forceinline__ unsigned pk2(float lo, float hi) { bf2_t v; v.x = (__bf16)lo; v.y = (__bf16)hi; return __builtin_bit_cast(unsigned, v); }
__device__ __forceinline__ float wave_sum(float v) {
#pragma unroll
    for (int o = 1; o < 64; o <<= 1) v += __shfl_xor(v, o);
    return v;
}
__device__ __forceinline__ float sigmoidf_(float x) { return __builtin_amdgcn_rcpf(1.0f + __expf(-x)); }
__device__ __forceinline__ float siluf_(float x) { return x * __builtin_amdgcn_rcpf(1.0f + __expf(-x)); }

template <class RM>
__device__ __forceinline__ void tr_item(const float* W, int ldw, int col0, bf16_t* WT, int ldk, int kb, int nb, RM rm, LAS float* scr) {
    const int tid = tidx();
    { const int n = tid & 63, kq = tid >> 6;
#pragma unroll
      for (int i = 0; i < 8; ++i) { const int k = kq * 8 + i; scr[k * 65 + n] = W[(size_t)(kb * 64 + k) * ldw + col0 + nb * 64 + n]; } }
    __syncthreads();
    { const int nn = tid >> 3, kc = (tid & 7) * 8;
      u32x4 o; o.x = pk2(scr[(kc + 0) * 65 + nn], scr[(kc + 1) * 65 + nn]); o.y = pk2(scr[(kc + 2) * 65 + nn], scr[(kc + 3) * 65 + nn]);
      o.z = pk2(scr[(kc + 4) * 65 + nn], scr[(kc + 5) * 65 + nn]); o.w = pk2(scr[(kc + 6) * 65 + nn], scr[(kc + 7) * 65 + nn]);
      *(u32x4*)(WT + (size_t)rm(nb * 64 + nn) * ldk + kb * 64 + kc) = o; }
    __syncthreads();
}
struct RmOff { int off; __device__ int operator()(int n) const { return n + off; } };
struct RmIl { int s; __device__ int operator()(int h) const { return 256 * (h >> 7) + 128 * ((h >> 2) & 1) + 32 * ((h >> 5) & 3) + 8 * ((h >> 3) & 3) + 4 * s + (h & 3); } };

constexpr int PREP_T_ABIN = 16 * 42, PREP_NTR = 16 * 42 + 256 + 16 * 44 + 256 + 4 * 16 * 44 + 2 * 44 * 16 + 2 * 12;
__device__ __forceinline__ void prep_transposes(const Params& p, LAS unsigned char* lds, int it0, int it1, int bid, int G) {
    const int tid = tidx();
    unsigned char* ws = p.ws;
    LAS float* scr = (LAS float*)lds;
    constexpr int T_ABIN = 16 * 42, T_SQ = 256, T_CDIN = 16 * 44, T_FF = 16 * 44, T_W2 = 44 * 16, T_G2 = 2 * 12;
    constexpr int NTR = T_ABIN + T_SQ + T_CDIN + T_SQ + 4 * T_FF + 2 * T_W2 + T_G2;
    for (int it = it0 + bid; it < it1; it += G) {
        int r = it;
        if (r < T_ABIN) { tr_item(p.in[I_ABWIN], 2944, 256, (bf16_t*)(ws + WS_WABIN), 1024, r / 42, r % 42, RmOff{512}, scr); continue; } r -= T_ABIN;
        if (r < T_SQ) { tr_item(p.in[I_ABWOUT], 1024, 0, (bf16_t*)(ws + WS_WABOUT), 1024, r / 16, r % 16, RmOff{0}, scr); continue; } r -= T_SQ;
        if (r < T_CDIN) { tr_item(p.in[I_CDWIN], 2816, 0, (bf16_t*)(ws + WS_WCDIN), 1024, r / 44, r % 44, RmOff{0}, scr); continue; } r -= T_CDIN;
        if (r < T_SQ) { tr_item(p.in[I_CDWOUT], 1024, 0, (bf16_t*)(ws + WS_WCDOUT), 1024, r / 16, r % 16, RmOff{0}, scr); continue; } r -= T_SQ;
        if (r < 4 * T_FF) { const int l = r / (2 * T_FF), s = (r / T_FF) & 1, q = r % T_FF;
            tr_item(p.in[s ? I_W3 : I_W1] + (size_t)l * 1024 * 2816, 2816, 0, (bf16_t*)(ws + WS_W13) + (size_t)l * 5632 * 1024, 1024, q / 44, q % 44, RmIl{s}, scr); continue; } r -= 4 * T_FF;
        if (r < 2 * T_W2) { const int l = r / T_W2, q = r % T_W2;
            tr_item(p.in[I_FW2] + (size_t)l * 2816 * 1024, 1024, 0, (bf16_t*)(ws + WS_W2) + (size_t)l * 1024 * 2816, 2816, q / 16, q % 16, RmOff{0}, scr); continue; } r -= 2 * T_W2;
        tr_item(p.in[I_G2], 768, 0, (bf16_t*)(ws + WS_G2), 256, r / 12, r % 12, RmOff{0}, scr);
    }
}
__device__ __forceinline__ void prep_fold_tables(const Params& p, LAS unsigned char* lds, int bid, int G) {
    const int tid = tidx();
    unsigned char* ws = p.ws;
    LAS float* scr = (LAS float*)lds;
    {
        LAS float* ct = scr + 64 * 65;
        for (int it = bid; it < 64; it += G) {
            const int g = it >> 4, kb = it & 15;
            { const int n = tid & 63, kq = tid >> 6;
#pragma unroll
              for (int i = 0; i < 8; ++i) { const int k = kq * 8 + i; scr[k * 65 + n] = p.in[I_ABWIN][(size_t)(kb * 64 + k) * 2944 + g * 64 + n]; } }
            if (tid < 64) { ct[tid] = cosf((float)tid * 0.09817477042468103f); ct[64 + tid] = sinf((float)tid * 0.09817477042468103f); }
            __syncthreads();
            const int k = tid & 63, qg = tid >> 6;
            float ac[8], as[8];
#pragma unroll
            for (int i = 0; i < 8; ++i) { ac[i] = 0.f; as[i] = 0.f; }
            for (int c = 0; c < 64; ++c) { const float w = scr[k * 65 + c];
#pragma unroll
                for (int i = 0; i < 8; ++i) { const int m = ((qg * 8 + i) * c) & 63; ac[i] += w * ct[m]; as[i] += w * ct[64 + m]; } }
            bf16_t* WT = (bf16_t*)(ws + WS_WABIN);
#pragma unroll
            for (int i = 0; i < 8; ++i) { const int q = qg * 8 + i;
                WT[(size_t)(g * 64 + q) * 1024 + kb * 64 + k] = f2bf(ac[i]); WT[(size_t)(256 + g * 64 + q) * 1024 + kb * 64 + k] = f2bf(as[i]); }
            __syncthreads();
        }
    }
    {
        const size_t gt = (size_t)bid * NT + tid, gs = (size_t)G * NT;
        unsigned* TX = (unsigned*)(ws + WS_TX);
        for (size_t i = gt; i < (size_t)2048 * 2048; i += gs) {
            const int pr = (int)(i >> 11), c2 = (int)(i & 2047) * 2; const int sn = c2 >= 2048; const int l = c2 & 2047;
            const float a0 = (float)((pr * l) & 2047) * (1.0f / 2048.0f), a1 = (float)((pr * (l + 1)) & 2047) * (1.0f / 2048.0f);
            TX[i] = sn ? pk2(-__builtin_amdgcn_sinf(a0), -__builtin_amdgcn_sinf(a1)) : pk2(__builtin_amdgcn_cosf(a0), __builtin_amdgcn_cosf(a1));
        }
        unsigned* TC = (unsigned*)(ws + WS_TC);
        for (size_t i = gt; i < (size_t)256 * 256; i += gs) {
            const int pr = (int)(i >> 8), c2 = (int)(i & 255) * 2; const int sn = c2 >= 256; const int l = c2 & 255;
            const float a0 = (float)((pr * l) & 255) * (1.0f / 256.0f), a1 = (float)((pr * (l + 1)) & 255) * (1.0f / 256.0f);
            TC[i] = sn ? pk2(-__builtin_amdgcn_sinf(a0), -__builtin_amdgcn_sinf(a1)) : pk2(__builtin_amdgcn_cosf(a0), __builtin_amdgcn_cosf(a1));
        }
        float* RP = (float*)(ws + WS_ROPE);
        for (size_t i = gt; i < (size_t)2048 * 32; i += gs) {
            const int t = (int)(i >> 5), pi = (int)(i & 31); const float pos = (pi < 16) ? (float)(t >> 6) : (float)(t & 63);
            const float fr = exp2f(-(float)(pi & 15) * (13.287712379549449f / 16.0f));
            const float ang = pos * fr; RP[t * 64 + pi] = cosf(ang); RP[t * 64 + 32 + pi] = sinf(ang);
        }
        unsigned* Z1 = (unsigned*)(ws + WS_WABIN + (size_t)3200 * 1024 * 2);
        for (size_t i = gt; i < (size_t)128 * 512; i += gs) Z1[i] = 0u;
        unsigned* Z2 = (unsigned*)(ws + WS_G2);
        for (size_t i = gt; i < (size_t)768 * 64; i += gs) { const int r = (int)(i >> 6), c = (int)(i & 63); Z2[r * 128 + 64 + c] = 0u; }
        float* SSZ = (float*)(ws + WS_SS);
        for (size_t i = gt; i < (size_t)2 * TOK; i += gs) SSZ[i] = 0.f;
    }
}
__device__ __forceinline__ void prep_mods(const Params& p, LAS unsigned char* lds, int bid, int G) {
    const int tid = tidx();
    unsigned char* ws = p.ws;
    LAS float* scr = (LAS float*)lds;
    {
        LAS float* sc = (LAS float*)lds;
        LAS float* part = sc + 17 * 1024;
        bool loaded = false;
        for (int it = bid; it < 192; it += G) {
            if (!loaded) { __syncthreads();
                for (int i = tid; i < 17 * 1024; i += NT) { const float v = (i < 16 * 1024) ? p.in[I_C][i] : p.in[I_CCTX][i - 16 * 1024]; sc[i] = siluf_(v); }
                loaded = true; __syncthreads(); }
            const int l = it / 96, jc = it % 96, j = tid & 63, kq = tid >> 6;
            const float* W = p.in[I_ADAW] + (size_t)l * 1024 * 6144 + jc * 64 + j;
            float acc[17];
#pragma unroll
            for (int r = 0; r < 17; ++r) acc[r] = 0.f;
#pragma unroll 1
            for (int k0 = kq * 128; k0 < kq * 128 + 128; k0 += 8) { float w[8];
#pragma unroll
                for (int e = 0; e < 8; ++e) w[e] = W[(size_t)(k0 + e) * 6144];
#pragma unroll
                for (int r = 0; r < 17; ++r) { const f32x4 s4 = *(const LAS f32x4*)(sc + r * 1024 + k0), s5 = *(const LAS f32x4*)(sc + r * 1024 + k0 + 4);
                    acc[r] += (s4.x * w[0] + s4.y * w[1] + s4.z * w[2] + s4.w * w[3]) + (s5.x * w[4] + s5.y * w[5] + s5.z * w[6] + s5.w * w[7]); } }
#pragma unroll
            for (int r = 0; r < 17; ++r) part[(kq * 17 + r) * 64 + j] = acc[r];
            __syncthreads();
            for (int o = tid; o < 17 * 64; o += NT) { const int r = o >> 6, jj = o & 63; float s = p.in[I_ADAB][l * 6144 + jc * 64 + jj];
#pragma unroll
                for (int q = 0; q < 8; ++q) s += part[(q * 17 + r) * 64 + jj];
                if (r < 16) ((float*)(ws + WS_MODX))[((size_t)l * 16 + r) * 6144 + jc * 64 + jj] = s; else ((float*)(ws + WS_MODC))[(size_t)l * 6144 + jc * 64 + jj] = s; }
            __syncthreads();
        }
    }
}
__device__ __forceinline__ void phase_modnorm(const Params& p, const float* latx, const float* latc, const float* g, int layer, int shift_idx, int nrows, int wg = -1, int nwg = 0) {
    if (wg < 0) { wg = blockIdx.x; nwg = gridDim.x; }
    const int lane = tidx() & 63, gw = wg * 8 + (tidx() >> 6), GW = nwg * 8;
    bf16_t* H = (bf16_t*)(p.ws + WS_HM);
    const float* modx = (const float*)(p.ws + WS_MODX) + (size_t)layer * 16 * 6144; const float* modc = (const float*)(p.ws + WS_MODC) + (size_t)layer * 6144;
    for (int row0 = gw * 2; row0 < nrows; row0 += GW * 2) {
        f32x4 v[2][2][2]; float ss[2] = {0.f, 0.f};
#pragma unroll
        for (int r = 0; r < 2; ++r) { const int row = row0 + r; const float* src = row < XR ? latx + (size_t)row * 1024 : latc + (size_t)(row - XR) * 1024;
#pragma unroll
            for (int j = 0; j < 2; ++j) { v[r][j][0] = __builtin_nontemporal_load((const f32x4*)(src + j * 512 + lane * 8)); v[r][j][1] = __builtin_nontemporal_load((const f32x4*)(src + j * 512 + lane * 8 + 4)); } }
#pragma unroll
        for (int r = 0; r < 2; ++r)
#pragma unroll
            for (int j = 0; j < 2; ++j)
#pragma unroll
                for (int h = 0; h < 2; ++h) ss[r] += v[r][j][h].x * v[r][j][h].x + v[r][j][h].y * v[r][j][h].y + v[r][j][h].z * v[r][j][h].z + v[r][j][h].w * v[r][j][h].w;
#pragma unroll
        for (int o = 1; o < 64; o <<= 1) { ss[0] += __shfl_xor(ss[0], o); ss[1] += __shfl_xor(ss[1], o); }
#pragma unroll
        for (int r = 0; r < 2; ++r) { const int row = row0 + r; const float rstd = rsqrtf(ss[r] * (1.0f / 1024.0f) + 1e-6f);
            const float* md = row < XR ? modx + (size_t)(row >> 11) * 6144 : modc; const float* sh = md + shift_idx * 1024; const float* sc = sh + 1024;
#pragma unroll
            for (int j = 0; j < 2; ++j) { const int c = j * 512 + lane * 8; unsigned w[4];
#pragma unroll
                for (int h = 0; h < 2; ++h) { const f32x4 gg = *(const f32x4*)(g + c + 4 * h), s1 = *(const f32x4*)(sc + c + 4 * h), s0 = *(const f32x4*)(sh + c + 4 * h), x = v[r][j][h];
                    w[2 * h] = pk2(x.x * rstd * gg.x * (1.f + s1.x) + s0.x, x.y * rstd * gg.y * (1.f + s1.y) + s0.y); w[2 * h + 1] = pk2(x.z * rstd * gg.z * (1.f + s1.z) + s0.z, x.w * rstd * gg.w * (1.f + s1.w) + s0.w); }
                *(u32x4*)(H + (size_t)row * 1024 + c) = (u32x4){w[0], w[1], w[2], w[3]}; } }
    }
}
__device__ __forceinline__ void phase_final_norm(const Params& p) {
    const int lane = tidx() & 63, gw = blockIdx.x * 8 + (tidx() >> 6), GW = gridDim.x * 8;
    const float* g = p.in[I_FINALG];
    auto loadrows = [&](int row0, f32x4 (&v)[2][4]) {
#pragma unroll
        for (int r = 0; r < 2; ++r) { const float* src = p.out + (size_t)(row0 + r) * 1024;
#pragma unroll
            for (int j = 0; j < 4; ++j) v[r][j] = *(const f32x4*)(src + j * 256 + lane * 4); } };
    auto procrows = [&](int row0, const f32x4 (&v)[2][4]) { float ss[2] = {0.f, 0.f};
#pragma unroll
        for (int r = 0; r < 2; ++r)
#pragma unroll
            for (int j = 0; j < 4; ++j) ss[r] += v[r][j].x * v[r][j].x + v[r][j].y * v[r][j].y + v[r][j].z * v[r][j].z + v[r][j].w * v[r][j].w;
#pragma unroll
        for (int o = 1; o < 64; o <<= 1) { ss[0] += __shfl_xor(ss[0], o); ss[1] += __shfl_xor(ss[1], o); }
#pragma unroll
        for (int r = 0; r < 2; ++r) { float* dst = p.out + (size_t)(row0 + r) * 1024; const float rstd = rsqrtf(ss[r] * (1.0f / 1024.0f) + 1e-6f);
#pragma unroll
            for (int j = 0; j < 4; ++j) { const int c = j * 256 + lane * 4; const f32x4 gg = *(const f32x4*)(g + c), x = v[r][j];
                f32x4 o; o.x = x.x * rstd * gg.x; o.y = x.y * rstd * gg.y; o.z = x.z * rstd * gg.z; o.w = x.w * rstd * gg.w; __builtin_nontemporal_store(o, (f32x4*)(dst + c)); } } };
    const int step = GW * 2; int row0 = gw * 2;
    f32x4 va[2][4], vb[2][4];
    if (row0 < XR) loadrows(row0, va);
    for (; row0 < XR; row0 += 2 * step) {
        const int r1 = row0 + step, r2 = r1 + step; const bool h1 = r1 < XR;
        if (h1) loadrows(r1, vb);
        procrows(row0, va);
        if (r2 < XR) loadrows(r2, va);
        if (h1) procrows(r1, vb);
    }
}

__device__ __forceinline__ void phase_swc(const Params& p) {
    const int lane = tidx() & 63, gw = blockIdx.x * 8 + (tidx() >> 6), GW = gridDim.x * 8;
    const float* MODC = (const float*)(p.ws + WS_MODC); float* SW = (float*)(p.ws + WS_SWC);
    for (int n = gw; n < 5632 + 2816; n += GW) {
        const bool ff = n < 5632; const bf16_t* Wt = ff ? (const bf16_t*)(p.ws + WS_W13) + (size_t)n * 1024 : (const bf16_t*)(p.ws + WS_WCDIN) + (size_t)(n - 5632) * 1024;
        const float* sh = ff ? MODC + 3 * 1024 : MODC + 6144;
        const u32x4 w0 = *(const u32x4*)(Wt + lane * 16), w1 = *(const u32x4*)(Wt + lane * 16 + 8);
        const float wv[16] = {bflo(w0.x), bfhi(w0.x), bflo(w0.y), bfhi(w0.y), bflo(w0.z), bfhi(w0.z), bflo(w0.w), bfhi(w0.w), bflo(w1.x), bfhi(w1.x), bflo(w1.y), bfhi(w1.y), bflo(w1.z), bfhi(w1.z), bflo(w1.w), bfhi(w1.w)};
        float s = 0.f;
#pragma unroll
        for (int q = 0; q < 4; ++q) { const f32x4 x = *(const f32x4*)(sh + lane * 16 + q * 4); s += wv[q * 4] * x.x + wv[q * 4 + 1] * x.y + wv[q * 4 + 2] * x.z + wv[q * 4 + 3] * x.w; }
        s = wave_sum(s); if (lane == 0) SW[n] = s;
    }
}
#define XB_TMO      128
#define XB_XCNT(j)  (256  + 64 * (j))
#define XB_XSUB(j)  (1280 + 64 * (j))
#define XB_XGEN(j)  (2304 + 64 * (j))
#define XB_TOP      3328
#define XB_TOPGEN   3392
#define XCD_BAR_WORDS 3456
#define XB_SPIN_CAP (1u << 18)

__device__ __forceinline__ unsigned xb_ld(unsigned* p)              { return __hip_atomic_load(p, __ATOMIC_RELAXED, __HIP_MEMORY_SCOPE_AGENT); }
__device__ __forceinline__ unsigned xb_add(unsigned* p, unsigned v) { return __hip_atomic_fetch_add(p, v, __ATOMIC_RELAXED, __HIP_MEMORY_SCOPE_AGENT); }
__device__ __forceinline__ unsigned xb_xcc_id() { return (unsigned)__builtin_amdgcn_s_getreg((3 << 11) | 20) & 0xFu; }
#define XB_SPIN(cond, bar) do { unsigned _sp = 0; while (cond) { __builtin_amdgcn_s_sleep(1); \
    if ((++_sp & 255u) == 0u) { if (xb_ld(&(bar)[XB_TMO])) break; if (_sp > XB_SPIN_CAP) { atomicAdd(&(bar)[XB_TMO], 1u); break; } } } } while (0)

struct XcdBarrier {
    unsigned* bar; unsigned x;
    volatile LAS unsigned* st;
};

__device__ __forceinline__ XcdBarrier xcd_barrier_post(unsigned* bar, volatile LAS unsigned* st) {
    XcdBarrier b; b.bar = bar; b.x = xb_xcc_id(); b.st = st;
    if (tidx() == 0) st[2] = xb_add(&bar[XB_XCNT(b.x)], 1u);
    return b;
}
__device__ __forceinline__ void xcd_barrier_complete(unsigned* bar, unsigned x, unsigned& nloc, unsigned& nx) {
    const unsigned G = gridDim.x * gridDim.y * gridDim.z;
    unsigned sum, cnt, mine, sp = 0u;
    for (;;) {
        sum = 0u; cnt = 0u; mine = 0u;
#pragma unroll
        for (unsigned j = 0; j < 16; ++j) { const unsigned c = xb_ld(&bar[XB_XCNT(j)]); sum += c; cnt += (c > 0u) ? 1u : 0u; mine = (j == x) ? c : mine; }
        if (sum == G) break;
        __builtin_amdgcn_s_sleep(1);
        if ((++sp & 255u) == 0u) { if (xb_ld(&bar[XB_TMO])) break; if (sp > XB_SPIN_CAP) { atomicAdd(&bar[XB_TMO], 1u); break; } }
    }
    nloc = mine > 0u ? mine : 1u; nx = cnt > 0u ? cnt : 1u;
}

__device__ __forceinline__ void xcd_barrier(const XcdBarrier& b) {
    asm volatile("s_waitcnt vmcnt(0)" ::: "memory");
    __syncthreads();
    if (tidx() == 0) {
        unsigned* bar = b.bar;
        __builtin_amdgcn_s_waitcnt(0);
        unsigned nloc = b.st[0], nx = b.st[1];
        if (nloc == 0u) { xcd_barrier_complete(bar, b.x, nloc, nx); b.st[0] = nloc; b.st[1] = nx; }
        const unsigned old = xb_add(&bar[XB_XSUB(b.x)], 1u);
        const unsigned gen = old / nloc;
        if (old + 1u == (gen + 1u) * nloc) {
            __builtin_amdgcn_fence(__ATOMIC_RELEASE, "agent");
            asm volatile("s_waitcnt vmcnt(0)" ::: "memory");
            const unsigned og = xb_add(&bar[XB_TOP], 1u);
            const unsigned tg = og / nx;
            if (og + 1u == (tg + 1u) * nx) xb_add(&bar[XB_TOPGEN], 1u);
            else XB_SPIN(xb_ld(&bar[XB_TOPGEN]) == tg, bar);
            __builtin_amdgcn_fence(__ATOMIC_ACQUIRE, "agent");
            xb_add(&bar[XB_XGEN(b.x)], 1u);
            asm volatile("s_waitcnt vmcnt(0)" ::: "memory");
        } else {
            XB_SPIN(xb_ld(&bar[XB_XGEN(b.x)]) == gen, bar);
            __builtin_amdgcn_fence(__ATOMIC_ACQUIRE, "agent");
            asm volatile("s_waitcnt vmcnt(0)" ::: "memory");
        }
    }
    __syncthreads();
}

#ifndef GEMM_ALIGN_EPI
#define GEMM_ALIGN_EPI true
#endif
#ifndef GEMM_SP2
#define GEMM_SP2 true
#endif
#define EPI_FOR_FRAGS \
    _Pragma("unroll") for (int ai = 0; ai < 2; ++ai) _Pragma("unroll") for (int m = 0; m < 4; ++m) _Pragma("unroll") for (int bj = 0; bj < 2; ++bj) _Pragma("unroll") for (int n = 0; n < 2; ++n)
#define EPI_ROW (u.pm * 256 + ai * 128 + wr * 64 + m * 16 + fr)
#define EPI_COL (u.pn * 256 + bj * 128 + wc * 32 + n * 16 + 4 * fq)
typedef const f32x4 (&AccRef)[2][2][4][2];

struct EpiAbIn {
    static constexpr bool PERM = true, AFTER_DRAIN = false;
    bf16_t* P; bf16_t* VTX; bf16_t* VTC;
    __device__ __forceinline__ void operator()(AccRef acc, const pg8::Unit& u, int wr, int wc, int fr, int fq) const {
        if (u.pn < 2) {
            EPI_FOR_FRAGS { const int row = EPI_ROW, col = u.pn * 256 + bj * 128 + wc * 32 + 8 * fq + 4 * n; const f32x4 v = acc[ai][bj][m][n];
                const int cs = col >> 8, gq = col & 255;
                bf16_t* dst; size_t st;
                if (row < XR) { const int b = row >> 11, l = row & 2047; dst = VTX + (size_t)(b * 256 + gq) * 4096 + cs * 2048 + l; st = 4096; }
                else { const int r2 = row - XR, b = r2 >> 8, l = r2 & 255; dst = VTC + (size_t)(b * 256 + gq) * 512 + cs * 256 + l; st = 512; }
                dst[0] = f2bf(v.x); dst[st] = f2bf(v.y); dst[2 * st] = f2bf(v.z); dst[3 * st] = f2bf(v.w); }
        } else {
#pragma unroll
            for (int ai = 0; ai < 2; ++ai)
#pragma unroll
                for (int m = 0; m < 4; ++m)
#pragma unroll
                    for (int bj = 0; bj < 2; ++bj) { const int row = u.pm * 256 + ai * 128 + wr * 64 + m * 16 + fr, col = u.pn * 256 + bj * 128 + wc * 32 + 8 * fq - 512;
                        const f32x4 v0 = acc[ai][bj][m][0], v1 = acc[ai][bj][m][1];
                        u32x4 w; w.x = cvt_pk_bf16(v0.x, v0.y); w.y = cvt_pk_bf16(v0.z, v0.w); w.z = cvt_pk_bf16(v1.x, v1.y); w.w = cvt_pk_bf16(v1.z, v1.w);
                        *(u32x4*)(P + (size_t)row * PW + col) = w; }
        }
    }
};
struct EpiBf16Plain {
    static constexpr bool PERM = true, AFTER_DRAIN = false;
    bf16_t* O; int ldo;
    __device__ __forceinline__ void operator()(AccRef acc, const pg8::Unit& u, int wr, int wc, int fr_, int fq_) const {
        int fr = fr_, fq = fq_; asm volatile("" : "+v"(fr), "+v"(fq));
#pragma unroll
        for (int ai = 0; ai < 2; ++ai)
#pragma unroll
            for (int m = 0; m < 4; ++m)
#pragma unroll
                for (int bj = 0; bj < 2; ++bj) { const int row = u.pm * 256 + ai * 128 + wr * 64 + m * 16 + fr, col = u.pn * 256 + bj * 128 + wc * 32 + 8 * fq;
                    const f32x4 v0 = acc[ai][bj][m][0], v1 = acc[ai][bj][m][1];
                    u32x4 w; w.x = cvt_pk_bf16(v0.x, v0.y); w.y = cvt_pk_bf16(v0.z, v0.w); w.z = cvt_pk_bf16(v1.x, v1.y); w.w = cvt_pk_bf16(v1.z, v1.w);
                    *(u32x4*)(O + (size_t)row * ldo + col) = w; }
    }
};
struct EpiDft {
    static constexpr bool PERM = false, AFTER_DRAIN = false;
    bf16_t* MX; int rowbase, L; float scale;
    __device__ __forceinline__ void operator()(AccRef acc, const pg8::Unit& u, int wr, int wc, int fr, int fq) const {
        EPI_FOR_FRAGS { const int pr = EPI_ROW, col = EPI_COL; const f32x4 v = acc[ai][bj][m][n]; const int b = col >> 8, gq = col & 255;
            u32x2 w; w.x = cvt_pk_bf16(v.x * scale, v.y * scale); w.y = cvt_pk_bf16(v.z * scale, v.w * scale);
            *(u32x2*)(MX + (size_t)(rowbase + b * L + pr) * 1024 + gq) = w; }
    }
};
struct EpiResid {
    static constexpr bool PERM = false, AFTER_DRAIN = false;
    const float* basex; const float* basec; float* outx; float* outc; const float* gatex  ; const float* gatec;
    __device__ __forceinline__ void operator()(AccRef acc, const pg8::Unit& u, int wr, int wc, int fr, int fq) const {
        const int row0 = u.pm * 256; const bool isx = row0 < XR; const float* gt = isx ? gatex + (size_t)(row0 >> 11) * 6144 : gatec;
        const float* bs0 = isx ? basex + (size_t)row0 * 1024 : basec + (size_t)(row0 - XR) * 1024; float* o0 = isx ? outx + (size_t)row0 * 1024 : outc + (size_t)(row0 - XR) * 1024;
        f32x4 g4[2][2];
#pragma unroll
        for (int bj = 0; bj < 2; ++bj)
#pragma unroll
            for (int n = 0; n < 2; ++n) g4[bj][n] = *(const f32x4*)(gt + u.pn * 256 + bj * 128 + wc * 32 + n * 16 + 4 * fq);
        EPI_FOR_FRAGS { const int rl = ai * 128 + wr * 64 + m * 16 + fr, col = EPI_COL; const f32x4 v = acc[ai][bj][m][n], gg = g4[bj][n];
            const f32x4 b4 = *(const f32x4*)(bs0 + (size_t)rl * 1024 + col); f32x4 r; r.x = b4.x + gg.x * v.x; r.y = b4.y + gg.y * v.y; r.z = b4.z + gg.z * v.z; r.w = b4.w + gg.w * v.w;
            *(f32x4*)(o0 + (size_t)rl * 1024 + col) = r; }
    }
};
struct EpiSwiglu {
    static constexpr bool PERM = true, AFTER_DRAIN = false;
    bf16_t* Gh;
    __device__ __forceinline__ void operator()(AccRef acc, const pg8::Unit& u, int wr, int wc, int fr, int fq) const {
#pragma unroll
        for (int ai = 0; ai < 2; ++ai)
#pragma unroll
            for (int m = 0; m < 4; ++m) { const int row = u.pm * 256 + ai * 128 + wr * 64 + m * 16 + fr, col = u.pn * 128 + wc * 32 + 8 * fq;
                const f32x4 a0 = acc[ai][0][m][0], b0 = acc[ai][0][m][1], a1 = acc[ai][1][m][0], b1 = acc[ai][1][m][1];
                u32x4 w; w.x = cvt_pk_bf16(siluf_(a0.x) * b0.x, siluf_(a0.y) * b0.y); w.y = cvt_pk_bf16(siluf_(a0.z) * b0.z, siluf_(a0.w) * b0.w);
                w.z = cvt_pk_bf16(siluf_(a1.x) * b1.x, siluf_(a1.y) * b1.y); w.w = cvt_pk_bf16(siluf_(a1.z) * b1.z, siluf_(a1.w) * b1.w);
                *(u32x4*)(Gh + (size_t)row * FF + col) = w; }
    }
};
struct CdInOrder {
    pg8::StaticOrder so; int G, c;
    __device__ void init(int G_, int c_) { so.init(XR, 2816, G_, c_); G = G_; c = c_; }
    __device__ bool next(int i, pg8::Unit& u) const {
        const int L = i * G + c; if (L < 1408) return so.next(i, u);
        const int L2 = L - 1408; if (L2 >= 80) return false;
        u.pm = 128 + L2 / 5; u.pn = 1 + L2 % 5; return true; }
    __device__ __forceinline__ void a_ready(const pg8::Unit&) const {}
    __device__ __forceinline__ void done(const pg8::Unit&) const {}
};
template <class Epi> __device__ __forceinline__ void run_gemm_cdin(LAS unsigned char* lds, const bf16_t* A, const bf16_t* Bt, const Epi& E, int vc) {
    pg8::Gemm g; g.A = A; g.Bt = Bt; g.M = TOK; g.N = 2816; g.K = 1024;
    CdInOrder S; S.init(gridDim.x, vc);
    pg8::gemm_phase<Epi, CdInOrder, GEMM_ALIGN_EPI, GEMM_SP2>(lds, g, S, E);
    __syncthreads();
}
struct EpiResidH {
    static constexpr bool PERM = false, AFTER_DRAIN = false;
    const float* base; float* out; const float* gate; const float* g; const float* scale; bf16_t* Hn; float* SS;
    __device__ __forceinline__ void operator()(AccRef acc, const pg8::Unit& u, int wr, int wc, int fr_, int fq_) const {
        int fr = fr_, fq = fq_; asm volatile("" : "+v"(fr), "+v"(fq));
        const int row0 = u.pm * 256;
        f32x4 g4[2][2], n4[2][2];
#pragma unroll
        for (int bj = 0; bj < 2; ++bj)
#pragma unroll
            for (int n = 0; n < 2; ++n) { const int col = u.pn * 256 + bj * 128 + wc * 32 + n * 16 + 4 * fq; g4[bj][n] = *(const f32x4*)(gate + col);
                const f32x4 a = *(const f32x4*)(g + col), s = *(const f32x4*)(scale + col); n4[bj][n] = (f32x4){a.x * (1.f + s.x), a.y * (1.f + s.y), a.z * (1.f + s.z), a.w * (1.f + s.w)}; }
#pragma unroll
        for (int ai = 0; ai < 2; ++ai)
#pragma unroll
            for (int m = 0; m < 4; ++m) { const int row = row0 + ai * 128 + wr * 64 + m * 16 + fr; float sq = 0.f;
#pragma unroll
                for (int bj = 0; bj < 2; ++bj)
#pragma unroll
                    for (int n = 0; n < 2; ++n) { const int col = u.pn * 256 + bj * 128 + wc * 32 + n * 16 + 4 * fq; const f32x4 v = acc[ai][bj][m][n];
                        const f32x4 b4 = *(const f32x4*)(base + (size_t)(row - XR) * 1024 + col), gg = g4[bj][n], nn = n4[bj][n];
                        f32x4 r; r.x = b4.x + gg.x * v.x; r.y = b4.y + gg.y * v.y; r.z = b4.z + gg.z * v.z; r.w = b4.w + gg.w * v.w;
                        *(f32x4*)(out + (size_t)(row - XR) * 1024 + col) = r; sq += (r.x * r.x + r.y * r.y) + (r.z * r.z + r.w * r.w);
                        u32x2 w; w.x = cvt_pk_bf16(r.x * nn.x, r.y * nn.y); w.y = cvt_pk_bf16(r.z * nn.z, r.w * nn.w);
                        *(u32x2*)(Hn + (size_t)row * 1024 + col) = w; }
                sq += __shfl_xor(sq, 16); sq += __shfl_xor(sq, 32);
                if (fq == 0) atomicAdd(SS + row, sq); }
    }
};
struct EpiSwigluCtx {
    static constexpr bool PERM = true, AFTER_DRAIN = false;
    bf16_t* Gh; const float* SS; const float* SW;
    __device__ __forceinline__ void operator()(AccRef acc, const pg8::Unit& u, int wr, int wc, int fr, int fq) const {
        const float* sw = SW + u.pn * 256 + wc * 32 + 8 * fq;
        f32x4 sa[2], sb[2];
#pragma unroll
        for (int bj = 0; bj < 2; ++bj) { sa[bj] = *(const f32x4*)(sw + bj * 128); sb[bj] = *(const f32x4*)(sw + bj * 128 + 4); }
#pragma unroll
        for (int ai = 0; ai < 2; ++ai)
#pragma unroll
            for (int m = 0; m < 4; ++m) { const int row = u.pm * 256 + ai * 128 + wr * 64 + m * 16 + fr, col = u.pn * 128 + wc * 32 + 8 * fq; const float rstd = rsqrtf(SS[row] * (1.0f / 1024.0f) + 1e-6f);
                unsigned w[4];
#pragma unroll
                for (int bj = 0; bj < 2; ++bj) { const f32x4 a0 = acc[ai][bj][m][0], b0 = acc[ai][bj][m][1];
                    const float a[4] = {a0.x * rstd + sa[bj].x, a0.y * rstd + sa[bj].y, a0.z * rstd + sa[bj].z, a0.w * rstd + sa[bj].w}, b[4] = {b0.x * rstd + sb[bj].x, b0.y * rstd + sb[bj].y, b0.z * rstd + sb[bj].z, b0.w * rstd + sb[bj].w};
                    w[2 * bj] = cvt_pk_bf16(siluf_(a[0]) * b[0], siluf_(a[1]) * b[1]); w[2 * bj + 1] = cvt_pk_bf16(siluf_(a[2]) * b[2], siluf_(a[3]) * b[3]); }
                *(u32x4*)(Gh + (size_t)row * FF + col) = (u32x4){w[0], w[1], w[2], w[3]}; }
    }
};
struct EpiCdIn {
    static constexpr bool PERM = true, AFTER_DRAIN = false;
    bf16_t* O; const float* SS; const float* SW;
    __device__ __forceinline__ void operator()(AccRef acc, const pg8::Unit& u, int wr, int wc, int fr_, int fq_) const {
        int fr = fr_, fq = fq_; asm volatile("" : "+v"(fr), "+v"(fq));
        const bool isc = u.pm >= XR / 256;
        f32x4 s4[2][2];
#pragma unroll
        for (int bj = 0; bj < 2; ++bj)
#pragma unroll
            for (int n = 0; n < 2; ++n) s4[bj][n] = isc ? *(const f32x4*)(SW + u.pn * 256 + bj * 128 + wc * 32 + 8 * fq + 4 * n) : (f32x4){0.f, 0.f, 0.f, 0.f};
#pragma unroll
        for (int ai = 0; ai < 2; ++ai)
#pragma unroll
            for (int m = 0; m < 4; ++m) { const int row = u.pm * 256 + ai * 128 + wr * 64 + m * 16 + fr; const float rstd = isc ? rsqrtf(SS[row] * (1.0f / 1024.0f) + 1e-6f) : 1.f;
#pragma unroll
                for (int bj = 0; bj < 2; ++bj) { const int col = u.pn * 256 + bj * 128 + wc * 32 + 8 * fq;
                    const f32x4 v0 = acc[ai][bj][m][0], v1 = acc[ai][bj][m][1], t0 = s4[bj][0], t1 = s4[bj][1];
                    u32x4 w; w.x = cvt_pk_bf16(v0.x * rstd + t0.x, v0.y * rstd + t0.y); w.y = cvt_pk_bf16(v0.z * rstd + t0.z, v0.w * rstd + t0.w); w.z = cvt_pk_bf16(v1.x * rstd + t1.x, v1.y * rstd + t1.y); w.w = cvt_pk_bf16(v1.z * rstd + t1.z, v1.w * rstd + t1.w);
                    *(u32x4*)(O + (size_t)row * PW + col) = w; } }
    }
};
struct CtxOrder {
    int ntn, G, c;
    __device__ bool next(int i, pg8::Unit& u) const { const int L = i * G + c; if (L >= 16 * ntn) return false; u.pm = 128 + L / ntn; u.pn = L % ntn; return true; }
    __device__ __forceinline__ void a_ready(const pg8::Unit&) const {}
    __device__ __forceinline__ void done(const pg8::Unit&) const {}
};
template <class Epi> __device__ __forceinline__ void run_gemm_ctx(LAS unsigned char* lds, const bf16_t* A, const bf16_t* Bt, int N, int K, const Epi& E, int G, int c) {
    pg8::Gemm g; g.A = A; g.Bt = Bt; g.M = TOK; g.N = N; { int kk_ = K; asm volatile("" : "+s"(kk_)); g.K = kk_; }
    CtxOrder S; S.ntn = N / 256; S.G = G; S.c = c;
    pg8::gemm_phase<Epi, CtxOrder, GEMM_ALIGN_EPI, GEMM_SP2>(lds, g, S, E);
    __syncthreads();
}
struct PanelOrder {
    int pm, ntn;
    __device__ bool next(int i, pg8::Unit& u) const { if (i >= ntn) return false; u.pm = pm; u.pn = i; return true; }
    __device__ __forceinline__ void a_ready(const pg8::Unit&) const {}
    __device__ __forceinline__ void done(const pg8::Unit&) const {}
};
template <class Epi> __device__ __forceinline__ void run_gemm_sub(LAS unsigned char* lds, const bf16_t* A, const bf16_t* Bt, int M, int N, int K, const Epi& E, int Gsub, int c) {
    pg8::Gemm g; g.A = A; g.Bt = Bt; g.M = M; g.N = N; g.K = K;
    pg8::StaticOrder S; S.init(M, N, Gsub, c);
    pg8::gemm_phase<Epi, pg8::StaticOrder, GEMM_ALIGN_EPI, GEMM_SP2>(lds, g, S, E);
    __syncthreads();
}
template <class Epi> __device__ __forceinline__ void run_gemm(LAS unsigned char* lds, const bf16_t* A, const bf16_t* Bt, int M, int N, int K, const Epi& E, int vc) {
    pg8::Gemm g; g.A = A; g.Bt = Bt; g.M = M; g.N = N; g.K = K;
    pg8::StaticOrder S; const int G = gridDim.x; S.init(M, N, G, vc);
    pg8::gemm_phase<Epi, pg8::StaticOrder, GEMM_ALIGN_EPI, GEMM_SP2>(lds, g, S, E);
    __syncthreads();
}

__device__ __forceinline__ void sgl_rows(const Params& p, int rbeg, int rend) {
    const int lane = tidx() & 63, gw = tidx() >> 6, GW = 8;
    const bf16_t* P = (const bf16_t*)(p.ws + WS_P); unsigned* SGL = (unsigned*)((unsigned char*)p.out + DO_SGL);
    const int c = 2560 + lane * 2;
    const float mp0 = p.in[I_MUP][c], mp1 = p.in[I_MUP][c + 1], mn0 = p.in[I_MUN][c], mn1 = p.in[I_MUN][c + 1];
    for (int row = rbeg + gw; row < rend; row += GW) {
        int t, L; if (row < XR) { t = row & 2047; L = 2048; } else { t = (row - XR) & 255; L = 256; }
        const unsigned w0 = *(const unsigned*)(P + (size_t)row * PW + c);
        const unsigned wm = t > 0 ? *(const unsigned*)(P + (size_t)(row - 1) * PW + c) : 0u;
        const unsigned wp = t < L - 1 ? *(const unsigned*)(P + (size_t)(row + 1) * PW + c) : 0u;
        const float a0 = bflo(w0), a1 = bfhi(w0);
        const float u0 = a0 + mp0 * (bflo(wm) - a0) + mn0 * (bflo(wp) - a0), u1 = a1 + mp1 * (bfhi(wm) - a1) + mn1 * (bfhi(wp) - a1);
        SGL[(size_t)row * 128 + lane] = pk2(sigmoidf_(u0), sigmoidf_(u1));
        SGL[(size_t)row * 128 + 64 + lane] = 0u;
    }
}

template <int CTRL> __device__ __forceinline__ float dppf(float x) { return __builtin_bit_cast(float, __builtin_amdgcn_update_dpp(0, __builtin_bit_cast(int, x), CTRL, 0xF, 0xF, true)); }
__device__ __forceinline__ float red8(float x) { x += dppf<0xB1>(x); x += dppf<0x4E>(x); x += dppf<0x141>(x); return x; }

template <int NBLK, int KS, bool SWA = false, bool SWB = false>
__device__ __forceinline__ void wave_mma(const LAS unsigned short* A, int lda, const LAS unsigned short* B, int ldb, f32x4 (&acc)[NBLK], int fr, int fq) {
    const int fqs = (fq ^ (fr >> 2)) & 3;
#pragma unroll
    for (int ks = 0; ks < KS; ++ks) { const bf16x8 a = *(const LAS bf16x8*)(A + fr * lda + ks * 32 + (SWA ? fqs : fq) * 8);
#pragma unroll
        for (int nb = 0; nb < NBLK; ++nb) { const bf16x8 b = *(const LAS bf16x8*)(B + (nb * 16 + fr) * ldb + ks * 32 + (SWB ? fqs : fq) * 8);
            acc[nb] = __builtin_amdgcn_mfma_f32_16x16x32_bf16(b, a, acc[nb], 0, 0, 0); } }
}

typedef float f32x2 __attribute__((ext_vector_type(2)));
__device__ __forceinline__ void scan_pair(const Params& p, LAS unsigned char* lds, int pairidx) {
    const int tid = tidx(), hw = tid >> 8, ht = tid & 255, lane = tid & 63, wq = (tid >> 6) & 3, fr = lane & 15, fq = lane >> 4;
    const int unit = pairidx * 2 + hw, dir = unit & 1, bh = unit >> 1, b = bh / 12, h = bh % 12;
    const bf16_t* P = (const bf16_t*)(p.ws + WS_P);
    bf16_t* Yd = (bf16_t*)((unsigned char*)p.out + (dir ? DO_YB : DO_YF));
    float* BON = (float*)(p.ws + WS_BONUS);
    LAS unsigned char* Lh = lds + hw * 73728;
    LAS float* FW = (LAS float*)Lh; LAS float* FBB = FW + 2048; LAS float* FKK = FBB + 2048; LAS float* FR = FKK + 2048; LAS float* FKD = FR + 2048; LAS float* FV = FKD + 2048;
    LAS unsigned short* RAW = (LAS unsigned short*)Lh;
    LAS unsigned short* TWb = (LAS unsigned short*)(Lh + 49152); LAS unsigned short* ALb = TWb + 32 * 72;
    LAS float* YBUF = (LAS float*)(Lh + 58368);
    LAS float* CC = (LAS float*)(Lh + 66560);
    LAS float* CST = (LAS float*)(Lh + 66816);
    LAS float* MU = (LAS float*)(Lh + 68096);
    __syncthreads();
    if (ht < 64) { const int j = ht; CST[j] = p.in[I_W0][dir * 768 + h * 64 + j]; CST[64 + j] = p.in[I_A0][dir * 768 + h * 64 + j]; CST[128 + j] = p.in[I_KK][h * 64 + j]; CST[192 + j] = p.in[I_KA][h * 64 + j]; CST[256 + j] = p.in[I_RK][h * 64 + j]; }
    for (int i = ht; i < 320; i += 256) { const int s = i >> 6, j = i & 63; const int col = s < 3 ? s * 768 + h * 64 + j : (s == 3 ? 2304 + dir * 64 + j : 2432 + dir * 64 + j); MU[i] = p.in[I_MUP][col]; MU[320 + i] = p.in[I_MUN][col]; }
    const int mm = wq & 1, np = wq >> 1;
    bf16x8 Bf[2][2];
    { const float* Wm = (mm ? p.in[I_A2] : p.in[I_W2]) + (size_t)dir * 64 * 768 + h * 64;
#pragma unroll
      for (int n2 = 0; n2 < 2; ++n2)
#pragma unroll
          for (int ks = 0; ks < 2; ++ks)
#pragma unroll
              for (int e = 0; e < 8; ++e) Bf[n2][ks][e] = (short)f2bf(Wm[(size_t)(ks * 32 + fq * 8 + e) * 768 + (np * 2 + n2) * 16 + fr]); }
    const int rl = lane >> 3, kc = lane & 7, vr0 = wq * 16 + rl * 2;
    f32x4 Sacc[4];
#pragma unroll
    for (int nb = 0; nb < 4; ++nb) Sacc[nb] = (f32x4){0.f, 0.f, 0.f, 0.f};
    LAS unsigned short* cAl = (LAS unsigned short*)Lh; LAS unsigned short* cBe = cAl + 32 * 72; LAS unsigned short* cKa = cBe + 32 * 72; LAS unsigned short* cRh = cKa + 32 * 72;
    LAS unsigned short* cKT = (LAS unsigned short*)(Lh + 18432); LAS unsigned short* cNBT = cKT + 2048; LAS unsigned short* cVT = cNBT + 2048; LAS unsigned short* cUT = cVT + 2048;
    LAS float* cLL = (LAS float*)(Lh + 34816);
    LAS unsigned short* cAK = (LAS unsigned short*)(Lh + 38912); LAS unsigned short* cRK = cAK + 1280; LAS unsigned short* cNRB = cRK + 1280;
    LAS unsigned short* cS0 = (LAS unsigned short*)(Lh + 46592);
    LAS float* cRHS = YBUF;
    LAS unsigned short* cLb = (LAS unsigned short*)(Lh + 55808);
    LAS float* GL = CC;
    u32x4 pre[6];
    auto blk_geom = [&](int blk, int& base, int& L, int& t0) { int lb; if (blk < 8) { base = XR + b * 256; L = 256; lb = blk; } else { base = b * 2048; L = 2048; lb = blk - 8; } t0 = dir ? (L - 32 - lb * 32) : lb * 32; };
    auto prefetch = [&](int blk) { int base, L, t0; blk_geom(blk, base, L, t0);
#pragma unroll
        for (int q = 0; q < 6; ++q) { const int c = ht + 256 * q; pre[q] = (u32x4){0u, 0u, 0u, 0u};
            if (c < 1360) { const int rr = c / 40, cc = c % 40, seg = cc >> 3, off = (cc & 7) * 8; const int t = t0 - 1 + rr;
                const int col = seg < 3 ? seg * 768 + h * 64 + off : (seg == 3 ? 2304 + dir * 64 + off : 2432 + dir * 64 + off);
                if (t >= 0 && t < L) pre[q] = *(const u32x4*)(P + (size_t)(base + t) * PW + col); } } };
    auto flush = [&](int blk) { int base, L, t0; blk_geom(blk, base, L, t0); const int t = ht >> 3, j8 = (ht & 7) * 8;
        const f32x4 y0 = *(const LAS f32x4*)(YBUF + t * 64 + j8), y1 = *(const LAS f32x4*)(YBUF + t * 64 + j8 + 4);
        u32x4 w; w.x = pk2(y0.x, y0.y); w.y = pk2(y0.z, y0.w); w.z = pk2(y1.x, y1.y); w.w = pk2(y1.z, y1.w);
        __builtin_nontemporal_store(w, (u32x4*)(Yd + (size_t)(base + t0 + t) * 768 + h * 64 + j8)); };
    prefetch(0);
    for (int blk = 0; blk < 72; ++blk) {
        int base, L, t0; blk_geom(blk, base, L, t0);
        __syncthreads();
        if (blk > 0) flush(blk - 1);
#pragma unroll
        for (int q = 0; q < 6; ++q) { const int c = ht + 256 * q; if (c < 1360) *(LAS u32x4*)(RAW + c * 8) = pre[q]; }
        __syncthreads();
        { const int jp = ht & 31, tg = ht >> 5;
#pragma unroll
          for (int s = 0; s < 5; ++s) { unsigned w[6];
#pragma unroll
              for (int rr = 0; rr < 6; ++rr) w[rr] = *(const LAS unsigned*)(RAW + (tg * 4 + rr) * 320 + s * 64 + 2 * jp);
              const float mp0 = MU[s * 64 + 2 * jp], mp1 = MU[s * 64 + 2 * jp + 1], mn0 = MU[320 + s * 64 + 2 * jp], mn1 = MU[320 + s * 64 + 2 * jp + 1];
#pragma unroll
              for (int tt = 0; tt < 4; ++tt) { const int t = tg * 4 + tt; const float a0 = bflo(w[tt + 1]), a1 = bfhi(w[tt + 1]);
                  const float u0 = a0 + mp0 * (bflo(w[tt]) - a0) + mn0 * (bflo(w[tt + 2]) - a0), u1 = a1 + mp1 * (bfhi(w[tt]) - a1) + mn1 * (bfhi(w[tt + 2]) - a1);
                  if (s == 0) *(LAS f32x2*)(FR + t * 64 + 2 * jp) = (f32x2){u0, u1};
                  else if (s == 1) *(LAS f32x2*)(FKD + t * 64 + 2 * jp) = (f32x2){u0, u1};
                  else if (s == 2) *(LAS f32x2*)(FV + t * 64 + 2 * jp) = (f32x2){u0, u1};
                  else if (s == 3) *(LAS unsigned*)(TWb + t * 72 + 2 * jp) = pk2(2.f * sigmoidf_(2.f * u0) - 1.f, 2.f * sigmoidf_(2.f * u1) - 1.f);
                  else *(LAS unsigned*)(ALb + t * 72 + 2 * jp) = pk2(u0, u1); } } }
        __syncthreads();
        {
#pragma unroll
          for (int mb = 0; mb < 2; ++mb) { f32x4 acc[2] = {{0.f, 0.f, 0.f, 0.f}, {0.f, 0.f, 0.f, 0.f}};
              const LAS unsigned short* A = (mm ? ALb : TWb) + mb * 16 * 72;
#pragma unroll
              for (int ks = 0; ks < 2; ++ks) { const bf16x8 a = *(const LAS bf16x8*)(A + fr * 72 + ks * 32 + fq * 8);
#pragma unroll
                  for (int n2 = 0; n2 < 2; ++n2) acc[n2] = __builtin_amdgcn_mfma_f32_16x16x32_bf16(Bf[n2][ks], a, acc[n2], 0, 0, 0); }
              LAS float* O = (mm ? FBB : FW) + (mb * 16 + fr) * 64 + np * 32 + fq * 4;
#pragma unroll
              for (int n2 = 0; n2 < 2; ++n2) *(LAS f32x4*)(O + n2 * 16) = acc[n2]; } }
        __syncthreads();
        { const int t = ht >> 3, jg = ht & 7, o = t * 64 + jg * 8;
          float wp[8], ap[8], kv[8], rv[8];
          { const f32x4 x0 = *(const LAS f32x4*)(FW + o), x1 = *(const LAS f32x4*)(FW + o + 4); wp[0] = x0.x; wp[1] = x0.y; wp[2] = x0.z; wp[3] = x0.w; wp[4] = x1.x; wp[5] = x1.y; wp[6] = x1.z; wp[7] = x1.w; }
          { const f32x4 x0 = *(const LAS f32x4*)(FBB + o), x1 = *(const LAS f32x4*)(FBB + o + 4); ap[0] = x0.x; ap[1] = x0.y; ap[2] = x0.z; ap[3] = x0.w; ap[4] = x1.x; ap[5] = x1.y; ap[6] = x1.z; ap[7] = x1.w; }
          { const f32x4 x0 = *(const LAS f32x4*)(FKD + o), x1 = *(const LAS f32x4*)(FKD + o + 4); kv[0] = x0.x; kv[1] = x0.y; kv[2] = x0.z; kv[3] = x0.w; kv[4] = x1.x; kv[5] = x1.y; kv[6] = x1.z; kv[7] = x1.w; }
          { const f32x4 x0 = *(const LAS f32x4*)(FR + o), x1 = *(const LAS f32x4*)(FR + o + 4); rv[0] = x0.x; rv[1] = x0.y; rv[2] = x0.z; rv[3] = x0.w; rv[4] = x1.x; rv[5] = x1.y; rv[6] = x1.z; rv[7] = x1.w; }
          float dec[8], av[8], kkv[8], kd[8], ss = 0.f, bs = 0.f;
#pragma unroll
          for (int e = 0; e < 8; ++e) { const int j = jg * 8 + e;
              dec[e] = __expf(-0.6065306597126334f * sigmoidf_(CST[j] + wp[e]));
              av[e] = sigmoidf_(CST[64 + j] + ap[e]);
              kkv[e] = kv[e] * CST[128 + j]; ss += kkv[e] * kkv[e];
              kd[e] = kv[e] * (1.f + (av[e] - 1.f) * CST[192 + j]);
              bs += rv[e] * kd[e] * CST[256 + j]; }
          ss = red8(ss); const float inv = rsqrtf(ss + 1e-12f);
          float bb[8];
#pragma unroll
          for (int e = 0; e < 8; ++e) { kkv[e] *= inv; bb[e] = kkv[e] * av[e]; }
          if (dir == 0) { bs = red8(bs); if (jg == 0) BON[(size_t)(base + t0 + t) * 12 + h] = bs; }
          *(LAS f32x4*)(FW + o) = (f32x4){dec[0], dec[1], dec[2], dec[3]}; *(LAS f32x4*)(FW + o + 4) = (f32x4){dec[4], dec[5], dec[6], dec[7]};
          *(LAS f32x4*)(FBB + o) = (f32x4){bb[0], bb[1], bb[2], bb[3]}; *(LAS f32x4*)(FBB + o + 4) = (f32x4){bb[4], bb[5], bb[6], bb[7]};
          *(LAS f32x4*)(FKK + o) = (f32x4){kkv[0], kkv[1], kkv[2], kkv[3]}; *(LAS f32x4*)(FKK + o + 4) = (f32x4){kkv[4], kkv[5], kkv[6], kkv[7]};
          *(LAS f32x4*)(FKD + o) = (f32x4){kd[0], kd[1], kd[2], kd[3]}; *(LAS f32x4*)(FKD + o + 4) = (f32x4){kd[4], kd[5], kd[6], kd[7]};
          *(LAS f32x4*)(FR + o) = (f32x4){rv[0], rv[1], rv[2], rv[3]}; *(LAS f32x4*)(FR + o + 4) = (f32x4){rv[4], rv[5], rv[6], rv[7]}; }
        __syncthreads();
        { const int k = ht & 63, part = ht >> 6;
          float g = 1.f;
#pragma unroll
          for (int i2 = 0; i2 < 24; ++i2) { const int t = dir ? 31 - i2 : i2; const float wv = FW[t * 64 + k]; g = (i2 < 8 * part) ? g * wv : g; }
          float al[8], be[8], ka[8], rh[8], vt[8];
#pragma unroll
          for (int e = 0; e < 8; ++e) { const int i = part * 8 + e, t = dir ? 31 - i : i; const int o = t * 64 + k;
              const float gp = g; g *= FW[o]; const float inv = __builtin_amdgcn_rcpf(g);
              al[e] = gp * FKK[o]; be[e] = FBB[o] * inv; ka[e] = FKD[o] * inv; rh[e] = (dir ? gp : g) * FR[o]; vt[e] = FV[o]; }
          __syncthreads();
#pragma unroll
          for (int e = 0; e < 8; ++e) { const int i = part * 8 + e; cAl[i * 72 + k] = f2bf(al[e]); cBe[i * 72 + k] = f2bf(be[e]); cKa[i * 72 + k] = f2bf(ka[e]); cRh[i * 72 + k] = f2bf(rh[e]); }
          { u32x4 w; w.x = pk2(ka[0], ka[1]); w.y = pk2(ka[2], ka[3]); w.z = pk2(ka[4], ka[5]); w.w = pk2(ka[6], ka[7]); *(LAS u32x4*)(cKT + k * 32 + ((part ^ (k >> 2)) & 3) * 8) = w; }
          { u32x4 w; w.x = pk2(-be[0], -be[1]); w.y = pk2(-be[2], -be[3]); w.z = pk2(-be[4], -be[5]); w.w = pk2(-be[6], -be[7]); *(LAS u32x4*)(cNBT + k * 32 + ((part ^ (k >> 2)) & 3) * 8) = w; }
          { u32x4 w; w.x = pk2(vt[0], vt[1]); w.y = pk2(vt[2], vt[3]); w.z = pk2(vt[4], vt[5]); w.w = pk2(vt[6], vt[7]); *(LAS u32x4*)(cVT + k * 32 + ((part ^ (k >> 2)) & 3) * 8) = w; }
          if (part == 3) GL[k] = g;
#pragma unroll
          for (int nb = 0; nb < 4; ++nb) { u32x2 w; w.x = pk2(Sacc[nb].x, Sacc[nb].y); w.y = pk2(Sacc[nb].z, Sacc[nb].w); *(LAS u32x2*)(cS0 + (wq * 16 + fr) * 72 + nb * 16 + fq * 4) = w; } }
        __syncthreads();
        const int cm = wq & 1, cset = wq >> 1, ci = cm * 16 + fr;
        { f32x4 accA[4], l2[2], k2[2];
#pragma unroll
          for (int nb = 0; nb < 4; ++nb) accA[nb] = (f32x4){0.f, 0.f, 0.f, 0.f};
#pragma unroll
          for (int nb = 0; nb < 2; ++nb) { l2[nb] = (f32x4){0.f, 0.f, 0.f, 0.f}; k2[nb] = (f32x4){0.f, 0.f, 0.f, 0.f}; }
          const LAS unsigned short* Arow = (cset ? cRh : cAl) + cm * 16 * 72;
          wave_mma<2, 2>(Arow, 72, cBe, 72, l2, fr, fq);
          wave_mma<2, 2>(Arow, 72, cKa, 72, k2, fr, fq);
          if (cset == 0) wave_mma<4, 2>(Arow, 72, cS0, 72, accA, fr, fq);
#pragma unroll
          for (int nb = 0; nb < 2; ++nb) { float lv[4] = {l2[nb].x, l2[nb].y, l2[nb].z, l2[nb].w}, kv2[4] = {k2[nb].x, k2[nb].y, k2[nb].z, k2[nb].w};
#pragma unroll
              for (int e = 0; e < 4; ++e) { const int j = nb * 16 + fq * 4 + e; const bool keep = cset ? (dir ? (j < ci) : (j <= ci)) : (j < ci);
                  lv[e] = keep ? lv[e] : 0.f; kv2[e] = keep ? kv2[e] : 0.f; }
              if (cset == 0) { *(LAS f32x4*)(cLL + ci * 32 + nb * 16 + fq * 4) = (f32x4){lv[0], lv[1], lv[2], lv[3]};
                  if (cm == 1) { u32x2 wl; wl.x = nb == 0 ? pk2(lv[0], lv[1]) : 0u; wl.y = nb == 0 ? pk2(lv[2], lv[3]) : 0u; *(LAS u32x2*)(cLb + fr * 40 + nb * 16 + fq * 4) = wl; }
                  u32x2 w; w.x = pk2(kv2[0], kv2[1]); w.y = pk2(kv2[2], kv2[3]); *(LAS u32x2*)(cAK + ci * 40 + nb * 16 + fq * 4) = w; }
              else { u32x2 w; w.x = pk2(-lv[0], -lv[1]); w.y = pk2(-lv[2], -lv[3]); *(LAS u32x2*)(cNRB + ci * 40 + nb * 16 + fq * 4) = w;
                  u32x2 w2; w2.x = pk2(kv2[0], kv2[1]); w2.y = pk2(kv2[2], kv2[3]); *(LAS u32x2*)(cRK + ci * 40 + nb * 16 + fq * 4) = w2; } }
          asm volatile("s_waitcnt lgkmcnt(0)" ::: "memory");
          if (cset == 0) { wave_mma<4, 1, false, true>(cAK + cm * 16 * 40, 40, cVT, 32, accA, fr, fq);
#pragma unroll
              for (int nb = 0; nb < 4; ++nb) *(LAS f32x4*)(cRHS + ci * 64 + nb * 16 + fq * 4) = accA[nb]; } }
        __syncthreads();
        if (wq == hw) { const int v = lane; int zz[6] = {0, 0, 0, 0, 0, 0};
            float u[16];
#pragma unroll
            for (int i = 0; i < 16; ++i) u[i] = 0.f;
#pragma unroll
            for (int i = 0; i < 16; ++i) { const int z = zz[i % 6]; float a0 = cRHS[i * 64 + v + z], a1 = 0.f;
#pragma unroll
                for (int j4 = 0; j4 < (i + 3) / 4; ++j4) { const f32x4 l = *(const LAS f32x4*)(cLL + i * 32 + j4 * 4 + z);
                    a0 -= l.x * u[j4 * 4]; a1 -= l.y * u[j4 * 4 + 1]; a0 -= l.z * u[j4 * 4 + 2]; a1 -= l.w * u[j4 * 4 + 3]; }
                u[i] = a0 + a1;
                asm volatile("" : "+v"(zz[i % 6]) : "v"(u[i])); }
            { u32x4 w; w.x = pk2(u[0], u[1]); w.y = pk2(u[2], u[3]); w.z = pk2(u[4], u[5]); w.w = pk2(u[6], u[7]); *(LAS u32x4*)(cUT + v * 32 + ((0 ^ (v >> 2)) & 3) * 8) = w;
              u32x4 w1; w1.x = pk2(u[8], u[9]); w1.y = pk2(u[10], u[11]); w1.z = pk2(u[12], u[13]); w1.w = pk2(u[14], u[15]); *(LAS u32x4*)(cUT + v * 32 + ((1 ^ (v >> 2)) & 3) * 8) = w1;
              *(LAS u32x4*)(cUT + v * 32 + ((2 ^ (v >> 2)) & 3) * 8) = (u32x4){0u, 0u, 0u, 0u}; *(LAS u32x4*)(cUT + v * 32 + ((3 ^ (v >> 2)) & 3) * 8) = (u32x4){0u, 0u, 0u, 0u}; }
            asm volatile("s_waitcnt lgkmcnt(0)" ::: "memory");
            { f32x4 cacc[4];
#pragma unroll
              for (int nb = 0; nb < 4; ++nb) cacc[nb] = (f32x4){0.f, 0.f, 0.f, 0.f};
              wave_mma<4, 1, false, true>(cLb, 40, cUT, 32, cacc, fr, fq);
#pragma unroll
              for (int nb = 0; nb < 4; ++nb) { LAS f32x4* rp = (LAS f32x4*)(cRHS + (16 + fr) * 64 + nb * 16 + fq * 4); f32x4 r = *rp; r.x -= cacc[nb].x; r.y -= cacc[nb].y; r.z -= cacc[nb].z; r.w -= cacc[nb].w; *rp = r; } }
            asm volatile("s_waitcnt lgkmcnt(0)" ::: "memory");
#pragma unroll
            for (int i = 0; i < 16; ++i) u[i] = 0.f;
#pragma unroll
            for (int i = 0; i < 16; ++i) { const int z = zz[i % 6]; float a0 = cRHS[(16 + i) * 64 + v + z], a1 = 0.f;
#pragma unroll
                for (int j4 = 0; j4 < (i + 3) / 4; ++j4) { const f32x4 l = *(const LAS f32x4*)(cLL + (16 + i) * 32 + 16 + j4 * 4 + z);
                    a0 -= l.x * u[j4 * 4]; a1 -= l.y * u[j4 * 4 + 1]; a0 -= l.z * u[j4 * 4 + 2]; a1 -= l.w * u[j4 * 4 + 3]; }
                u[i] = a0 + a1;
                asm volatile("" : "+v"(zz[i % 6]) : "v"(u[i])); }
            { u32x4 w; w.x = pk2(u[0], u[1]); w.y = pk2(u[2], u[3]); w.z = pk2(u[4], u[5]); w.w = pk2(u[6], u[7]); *(LAS u32x4*)(cUT + v * 32 + ((2 ^ (v >> 2)) & 3) * 8) = w;
              u32x4 w1; w1.x = pk2(u[8], u[9]); w1.y = pk2(u[10], u[11]); w1.z = pk2(u[12], u[13]); w1.w = pk2(u[14], u[15]); *(LAS u32x4*)(cUT + v * 32 + ((3 ^ (v >> 2)) & 3) * 8) = w1; } }
        __syncthreads();
        if (blk + 1 < 72) prefetch(blk + 1);
        if (cset == 1) { f32x4 accA[4];
#pragma unroll
            for (int nb = 0; nb < 4; ++nb) accA[nb] = (f32x4){0.f, 0.f, 0.f, 0.f};
            wave_mma<4, 2>(cRh + cm * 16 * 72, 72, cS0, 72, accA, fr, fq);
            wave_mma<4, 1, false, true>(cRK + cm * 16 * 40, 40, cVT, 32, accA, fr, fq);
            wave_mma<4, 1, false, true>(cNRB + cm * 16 * 40, 40, cUT, 32, accA, fr, fq); const int t = dir ? 31 - ci : ci;
#pragma unroll
            for (int nb = 0; nb < 4; ++nb) *(LAS f32x4*)(YBUF + t * 64 + nb * 16 + fq * 4) = accA[nb]; }
        wave_mma<4, 1, true, true>(cVT + wq * 16 * 32, 32, cKT, 32, Sacc, fr, fq);
        wave_mma<4, 1, true, true>(cUT + wq * 16 * 32, 32, cNBT, 32, Sacc, fr, fq);
#pragma unroll
        for (int nb = 0; nb < 4; ++nb) { const f32x4 g4 = *(const LAS f32x4*)(GL + nb * 16 + fq * 4); Sacc[nb].x *= g4.x; Sacc[nb].y *= g4.y; Sacc[nb].z *= g4.z; Sacc[nb].w *= g4.w; }
    }
    __syncthreads();
    flush(71);
}
__device__ __forceinline__ void phase_scan(const Params& p, LAS unsigned char* lds) {
    const int bid = blockIdx.x, G = gridDim.x;
    const int NS = G >= 256 ? 192 : G;
    if (bid < NS) for (int w = bid; w < 192; w += NS) scan_pair(p, lds, w);
    const bool split = G >= 256; const int Gd = split ? G - 192 : G, cd = split ? bid - 192 : bid;
    if (!split || bid >= 192) {
        bf16_t* HM = (bf16_t*)(p.ws + WS_HM);
        EpiDft E; E.MX = HM; E.rowbase = 0; E.L = 2048; E.scale = 0.0027621358640099515f;
        run_gemm_sub(lds, (const bf16_t*)(p.ws + WS_TX), (const bf16_t*)(p.ws + WS_VTX), 2048, 4096, 4096, E, Gd, cd);
        EpiDft E2; E2.MX = HM; E2.rowbase = XR; E2.L = 256; E2.scale = 0.0078125f;
        run_gemm_sub(lds, (const bf16_t*)(p.ws + WS_TC), (const bf16_t*)(p.ws + WS_VTC), 256, 4096, 512, E2, Gd, cd);
        for (int pm = cd; pm < TOK / 256; pm += Gd) {
            sgl_rows(p, pm * 256, pm * 256 + 256);
            __threadfence(); __syncthreads();
            pg8::Gemm g; g.A = (const bf16_t*)((unsigned char*)p.out + DO_SGL); g.Bt = (const bf16_t*)(p.ws + WS_G2); g.M = TOK; g.N = 768; { int kk_ = 256; asm volatile("" : "+s"(kk_)); g.K = kk_; }
            PanelOrder S; S.pm = pm; S.ntn = 3; EpiBf16Plain Eg; Eg.O = (bf16_t*)(p.ws + WS_GG); Eg.ldo = 768;
            pg8::gemm_phase<EpiBf16Plain, PanelOrder, GEMM_ALIGN_EPI, GEMM_SP2>(lds, g, S, Eg);
            __syncthreads();
        }
        prep_transposes(p, lds, 672, 3296, cd, Gd);
        prep_transposes(p, lds, 4704, 5408, cd, Gd);
        prep_transposes(p, lds, 3296, 4704, cd, Gd);
        prep_transposes(p, lds, 5408, 6112, cd, Gd);
    }
}

__device__ __forceinline__ void phase_rwkv_out(const Params& p) {
    const int lane = tidx() & 63, gw = blockIdx.x * 8 + (tidx() >> 6), GW = gridDim.x * 8;
    const bf16_t* P = (const bf16_t*)(p.ws + WS_P); const bf16_t* YF = (const bf16_t*)((unsigned char*)p.out + DO_YF); const bf16_t* YB = (const bf16_t*)((unsigned char*)p.out + DO_YB);
    const bf16_t* GG = (const bf16_t*)(p.ws + WS_GG); const float* BON = (const float*)(p.ws + WS_BONUS); bf16_t* MX = (bf16_t*)(p.ws + WS_HM);
    for (int row0 = gw * 2; row0 < TOK; row0 += GW * 2) {
#pragma unroll
        for (int ps = 0; ps < 3; ++ps) {
            const int s = ps * 64 + lane, rsel = s >= 96 ? 1 : 0, ch = (s - rsel * 96) * 8, hh = ch >> 6; const int row = row0 + rsel;
            int t, L; if (row < XR) { t = row & 2047; L = 2048; } else { t = (row - XR) & 255; L = 256; }
            const u32x4 yf = __builtin_nontemporal_load((const u32x4*)(YF + (size_t)row * 768 + ch)), yb = __builtin_nontemporal_load((const u32x4*)(YB + (size_t)row * 768 + ch)), gg = __builtin_nontemporal_load((const u32x4*)(GG + (size_t)row * 768 + ch));
            const int vc = 1536 + ch;
            const u32x4 v0 = *(const u32x4*)(P + (size_t)row * PW + vc);
            const u32x4 vm = t > 0 ? *(const u32x4*)(P + (size_t)(row - 1) * PW + vc) : (u32x4){0u, 0u, 0u, 0u};
            const u32x4 vp = t < L - 1 ? *(const u32x4*)(P + (size_t)(row + 1) * PW + vc) : (u32x4){0u, 0u, 0u, 0u};
            const unsigned yfw[4] = {yf.x, yf.y, yf.z, yf.w}, ybw[4] = {yb.x, yb.y, yb.z, yb.w}, ggw[4] = {gg.x, gg.y, gg.z, gg.w}, v0w[4] = {v0.x, v0.y, v0.z, v0.w}, vmw[4] = {vm.x, vm.y, vm.z, vm.w}, vpw[4] = {vp.x, vp.y, vp.z, vp.w};
            float y[8]; float sm = 0.f;
#pragma unroll
            for (int e = 0; e < 4; ++e) { y[2 * e] = bflo(yfw[e]) + bflo(ybw[e]); y[2 * e + 1] = bfhi(yfw[e]) + bfhi(ybw[e]); sm += y[2 * e] + y[2 * e + 1]; }
            const float mu = red8(sm) * (1.f / 64.f); float q = 0.f;
#pragma unroll
            for (int e = 0; e < 8; ++e) { y[e] -= mu; q += y[e] * y[e]; }
            const float rs = rsqrtf(red8(q) * (1.f / 64.f) + 64e-5f);
            const float bon = BON[(size_t)row * 12 + hh];
            float mp[8], mn[8], lg[8], lb[8];
            { const f32x4 a0 = *(const f32x4*)(p.in[I_MUP] + vc), a1 = *(const f32x4*)(p.in[I_MUP] + vc + 4), b0 = *(const f32x4*)(p.in[I_MUN] + vc), b1 = *(const f32x4*)(p.in[I_MUN] + vc + 4);
              const f32x4 c0 = *(const f32x4*)(p.in[I_LNXG] + ch), c1 = *(const f32x4*)(p.in[I_LNXG] + ch + 4), d0 = *(const f32x4*)(p.in[I_LNXB] + ch), d1 = *(const f32x4*)(p.in[I_LNXB] + ch + 4);
              mp[0] = a0.x; mp[1] = a0.y; mp[2] = a0.z; mp[3] = a0.w; mp[4] = a1.x; mp[5] = a1.y; mp[6] = a1.z; mp[7] = a1.w;
              mn[0] = b0.x; mn[1] = b0.y; mn[2] = b0.z; mn[3] = b0.w; mn[4] = b1.x; mn[5] = b1.y; mn[6] = b1.z; mn[7] = b1.w;
              lg[0] = c0.x; lg[1] = c0.y; lg[2] = c0.z; lg[3] = c0.w; lg[4] = c1.x; lg[5] = c1.y; lg[6] = c1.z; lg[7] = c1.w;
              lb[0] = d0.x; lb[1] = d0.y; lb[2] = d0.z; lb[3] = d0.w; lb[4] = d1.x; lb[5] = d1.y; lb[6] = d1.z; lb[7] = d1.w; }
            float o8[8];
#pragma unroll
            for (int e = 0; e < 8; ++e) { const unsigned w0 = v0w[e >> 1], wm = vmw[e >> 1], wp = vpw[e >> 1], wg = ggw[e >> 1];
                const float p0 = (e & 1) ? bfhi(w0) : bflo(w0), pm = (e & 1) ? bfhi(wm) : bflo(wm), pp = (e & 1) ? bfhi(wp) : bflo(wp), g1 = (e & 1) ? bfhi(wg) : bflo(wg);
                const float uv = p0 + mp[e] * (pm - p0) + mn[e] * (pp - p0);
                const float yn = y[e] * rs * lg[e] + lb[e]; o8[e] = (yn + bon * uv) * g1; }
            u32x4 w; w.x = pk2(o8[0], o8[1]); w.y = pk2(o8[2], o8[3]); w.z = pk2(o8[4], o8[5]); w.w = pk2(o8[6], o8[7]);
            *(u32x4*)(MX + (size_t)row * 1024 + 256 + ch) = w;
        }
    }
}
__device__ __forceinline__ void retention_unit(const Params& p, LAS unsigned char* lds, int unit) {
    const int tid = tidx(), lane = tid & 63, wave = tid >> 6, fr = lane & 15, fq = lane >> 4;
    const int dir = unit / 96, rem = unit % 96, b = rem / 6, h = rem % 6;
    const bf16_t* P = (const bf16_t*)(p.ws + WS_P); const float* RP = (const float*)(p.ws + WS_ROPE);
    bf16_t* Yd = (bf16_t*)(p.ws + (dir ? WS_YRB : WS_YRF));
    constexpr int LQ = 72, LT = 136;
    LAS unsigned short* Qs = (LAS unsigned short*)lds;
    LAS unsigned short* Ks = Qs + 128 * LQ;
    LAS unsigned short* Ss = Qs;
    LAS unsigned short* KTs = Ks + 128 * LQ;
    LAS unsigned short* VTs = KTs + 64 * LT;
    LAS unsigned short* RTs = VTs + 128 * LT;
    const float lg = -__expf(p.in[I_DECAYP][dir * 6 + h]);
    const float cdec = __expf(lg * 128.f);
    f32x4 racc[4];
#pragma unroll
    for (int nb = 0; nb < 4; ++nb) racc[nb] = (f32x4){0.f, 0.f, 0.f, 0.f};
    __syncthreads();
    for (int i = tid; i < 128 * LQ; i += NT) RTs[i] = 0;
    u32x4 pk_lo, pk_hi, pq_lo, pq_hi, pv[4]; f32x4 pc[2], ps[2];
    auto chunk_geom = [&](int ch, bool& isctx, int& L, int& base, int& n) { isctx = ch < 2; L = isctx ? 256 : 2048; base = isctx ? XR + b * 256 : b * 2048; n = isctx ? ch : ch - 2; };
    auto prefetch = [&](int ch) { bool isctx; int L, base, n; chunk_geom(ch, isctx, L, base, n);
        const int i = tid & 127, part = tid >> 7; const int pos = n * 128 + i; const int t = dir ? (L - 1 - pos) : pos; const size_t ro = (size_t)(base + t) * PW;
        pk_lo = *(const u32x4*)(P + ro + 384 + h * 64 + part * 8); pk_hi = *(const u32x4*)(P + ro + 384 + h * 64 + 32 + part * 8);
#pragma unroll
        for (int q = 0; q < 4; ++q) pv[q] = *(const u32x4*)(P + ro + 768 + h * 128 + part * 32 + q * 8);
        if (!isctx) { pq_lo = *(const u32x4*)(P + ro + h * 64 + part * 8); pq_hi = *(const u32x4*)(P + ro + h * 64 + 32 + part * 8);
            pc[0] = *(const f32x4*)(RP + t * 64 + part * 8); pc[1] = *(const f32x4*)(RP + t * 64 + part * 8 + 4); ps[0] = *(const f32x4*)(RP + t * 64 + 32 + part * 8); ps[1] = *(const f32x4*)(RP + t * 64 + 32 + part * 8 + 4); } };
    prefetch(0);
    for (int ch = 0; ch < 18; ++ch) {
        bool isctx; int L, base, n; chunk_geom(ch, isctx, L, base, n);
        __syncthreads();
        {
            const int i = tid & 127, part = tid >> 7;
            const float kdcy = __expf(lg * (float)(127 - i)) * 0.125f;
            const float cv[8] = {pc[0].x, pc[0].y, pc[0].z, pc[0].w, pc[1].x, pc[1].y, pc[1].z, pc[1].w}, sv8[8] = {ps[0].x, ps[0].y, ps[0].z, ps[0].w, ps[1].x, ps[1].y, ps[1].z, ps[1].w};
            { const unsigned lw[4] = {pk_lo.x, pk_lo.y, pk_lo.z, pk_lo.w}, hw[4] = {pk_hi.x, pk_hi.y, pk_hi.z, pk_hi.w}; float o1[8], o2[8];
#pragma unroll
              for (int e = 0; e < 8; ++e) { const float t1 = (e & 1) ? bfhi(lw[e >> 1]) : bflo(lw[e >> 1]), t2 = (e & 1) ? bfhi(hw[e >> 1]) : bflo(hw[e >> 1]); const int d = part * 8 + e;
                  const float c = isctx ? 1.f : cv[e], s = isctx ? 0.f : sv8[e];
                  o1[e] = t1 * c - t2 * s; o2[e] = t1 * s + t2 * c;
                  KTs[d * LT + i] = f2bf(o1[e] * kdcy); KTs[(d + 32) * LT + i] = f2bf(o2[e] * kdcy); }
              if (!isctx) { u32x4 w; w.x = pk2(o1[0] * 0.125f, o1[1] * 0.125f); w.y = pk2(o1[2] * 0.125f, o1[3] * 0.125f); w.z = pk2(o1[4] * 0.125f, o1[5] * 0.125f); w.w = pk2(o1[6] * 0.125f, o1[7] * 0.125f);
                  *(LAS u32x4*)(Ks + i * LQ + part * 8) = w;
                  u32x4 w2; w2.x = pk2(o2[0] * 0.125f, o2[1] * 0.125f); w2.y = pk2(o2[2] * 0.125f, o2[3] * 0.125f); w2.z = pk2(o2[4] * 0.125f, o2[5] * 0.125f); w2.w = pk2(o2[6] * 0.125f, o2[7] * 0.125f);
                  *(LAS u32x4*)(Ks + i * LQ + 32 + part * 8) = w2; } }
            if (!isctx) { const unsigned lw[4] = {pq_lo.x, pq_lo.y, pq_lo.z, pq_lo.w}, hw[4] = {pq_hi.x, pq_hi.y, pq_hi.z, pq_hi.w}; float o1[8], o2[8];
#pragma unroll
              for (int e = 0; e < 8; ++e) { const float t1 = (e & 1) ? bfhi(lw[e >> 1]) : bflo(lw[e >> 1]), t2 = (e & 1) ? bfhi(hw[e >> 1]) : bflo(hw[e >> 1]);
                  o1[e] = t1 * cv[e] - t2 * sv8[e]; o2[e] = t1 * sv8[e] + t2 * cv[e]; }
              u32x4 w; w.x = pk2(o1[0], o1[1]); w.y = pk2(o1[2], o1[3]); w.z = pk2(o1[4], o1[5]); w.w = pk2(o1[6], o1[7]); *(LAS u32x4*)(Qs + i * LQ + part * 8) = w;
              u32x4 w2; w2.x = pk2(o2[0], o2[1]); w2.y = pk2(o2[2], o2[3]); w2.z = pk2(o2[4], o2[5]); w2.w = pk2(o2[6], o2[7]); *(LAS u32x4*)(Qs + i * LQ + 32 + part * 8) = w2; }
#pragma unroll
            for (int q = 0; q < 4; ++q) { const unsigned vw[4] = {pv[q].x, pv[q].y, pv[q].z, pv[q].w};
#pragma unroll
                for (int e = 0; e < 8; ++e) { const int vrow = (2 * part + (e >> 2)) * 16 + 4 * q + (e & 3);
                    VTs[vrow * LT + i] = (unsigned short)((e & 1) ? (vw[e >> 1] >> 16) : (vw[e >> 1] & 0xffffu)); } }
        }
        if (ch + 1 < 18) prefetch(ch + 1);
        __syncthreads();
        f32x4 oacc[8];
        if (!isctx) {
            f32x4 sacc[8];
#pragma unroll
            for (int nb = 0; nb < 8; ++nb) { sacc[nb] = (f32x4){0.f, 0.f, 0.f, 0.f}; oacc[nb] = (f32x4){0.f, 0.f, 0.f, 0.f}; }
            wave_mma<8, 2>(Qs + wave * 16 * LQ, LQ, Ks, LQ, sacc, fr, fq);
            wave_mma<8, 2>(Qs + wave * 16 * LQ, LQ, RTs, LQ, oacc, fr, fq);
            const int qi = wave * 16 + fr; const float qd = __expf(lg * (float)(qi + 1));
#pragma unroll
            for (int nb = 0; nb < 8; ++nb) { oacc[nb].x *= qd; oacc[nb].y *= qd; oacc[nb].z *= qd; oacc[nb].w *= qd; }
            __syncthreads();
#pragma unroll
            for (int nb = 0; nb < 8; ++nb) { float sv[4] = {sacc[nb].x, sacc[nb].y, sacc[nb].z, sacc[nb].w};
#pragma unroll
                for (int e = 0; e < 4; ++e) { const int jj = nb * 16 + fq * 4 + e; const int df = qi - jj; const bool keep = dir ? (df > 0) : (df >= 0);
                    sv[e] = keep ? sv[e] * __expf(lg * (float)df) : 0.f; }
                u32x2 w; w.x = pk2(sv[0], sv[1]); w.y = pk2(sv[2], sv[3]); *(LAS u32x2*)(Ss + qi * LT + nb * 16 + fq * 4) = w; }
            __syncthreads();
            wave_mma<8, 4>(Ss + wave * 16 * LT, LT, VTs, LT, oacc, fr, fq);
            { const int pos = n * 128 + qi; const int t = dir ? (L - 1 - pos) : pos; bf16_t* dst = Yd + (size_t)(base + t) * 768 + h * 128;
#pragma unroll
              for (int j = 0; j < 4; ++j) { u32x4 w; w.x = pk2(oacc[2 * j].x, oacc[2 * j].y); w.y = pk2(oacc[2 * j].z, oacc[2 * j].w); w.z = pk2(oacc[2 * j + 1].x, oacc[2 * j + 1].y); w.w = pk2(oacc[2 * j + 1].z, oacc[2 * j + 1].w);
                  __builtin_nontemporal_store(w, (u32x4*)(dst + 32 * j + 8 * fq)); } }
        }
#pragma unroll
        for (int nb = 0; nb < 4; ++nb) { racc[nb].x *= cdec; racc[nb].y *= cdec; racc[nb].z *= cdec; racc[nb].w *= cdec; }
        wave_mma<4, 4>(VTs + wave * 16 * LT, LT, KTs, LT, racc, fr, fq);
        __syncthreads();
#pragma unroll
        for (int nb = 0; nb < 4; ++nb) { u32x2 w; w.x = pk2(racc[nb].x, racc[nb].y); w.y = pk2(racc[nb].z, racc[nb].w); *(LAS u32x2*)(RTs + (wave * 16 + fr) * LQ + nb * 16 + fq * 4) = w; }
    }
}

__device__ __forceinline__ void conv_item(const Params& p, LAS unsigned char* lds, int item) {
    const int tid = tidx(), lane = tid & 63, wave = tid >> 6;
    const int b = item >> 6, t0 = (item & 63) * 32;
    const bf16_t* P = (const bf16_t*)(p.ws + WS_P); bf16_t* MX = (bf16_t*)(p.ws + WS_HM);
    LAS float* Hs = (LAS float*)lds;
    LAS float* Cs = Hs + 62 * 256;
    __syncthreads();
    for (int i = tid; i < 62 * 32; i += NT) { const int rr = i >> 5, c8 = (i & 31) * 8; const int t = t0 - 15 + rr; float hv[8];
#pragma unroll
        for (int e = 0; e < 8; ++e) hv[e] = 0.f;
        if (t >= 0 && t < 2048) { const size_t ro = (size_t)(b * 2048 + t) * PW + 2304; const u32x4 a = *(const u32x4*)(P + ro + c8), g = *(const u32x4*)(P + ro + 256 + c8);
            const unsigned aw[4] = {a.x, a.y, a.z, a.w}, gw[4] = {g.x, g.y, g.z, g.w};
#pragma unroll
            for (int e = 0; e < 4; ++e) { hv[2 * e] = bflo(aw[e]) * sigmoidf_(bflo(gw[e])); hv[2 * e + 1] = bfhi(aw[e]) * sigmoidf_(bfhi(gw[e])); } }
        *(LAS f32x4*)(Hs + rr * 256 + c8) = (f32x4){hv[0], hv[1], hv[2], hv[3]}; *(LAS f32x4*)(Hs + rr * 256 + c8 + 4) = (f32x4){hv[4], hv[5], hv[6], hv[7]}; }
    __syncthreads();
    { const int c = tid & 255, th = tid >> 8; float w[31], hwin[46];
#pragma unroll
      for (int j = 0; j < 31; ++j) w[j] = p.in[I_CONVW][j * 256 + c];
      const float cb = p.in[I_CONVB][c];
#pragma unroll
      for (int r = 0; r < 46; ++r) hwin[r] = Hs[(th * 16 + r) * 256 + c];
#pragma unroll
      for (int tt = 0; tt < 16; ++tt) { float s0 = cb, s1 = 0.f;
#pragma unroll
          for (int j = 0; j < 30; j += 2) { s0 += hwin[tt + j] * w[j]; s1 += hwin[tt + j + 1] * w[j + 1]; }
          s0 += hwin[tt + 30] * w[30];
          Cs[(th * 16 + tt) * 256 + c] = s0 + s1; } }
    __syncthreads();
    for (int tt = 0; tt < 4; ++tt) { const int t = wave * 4 + tt; const f32x4 v = *(const LAS f32x4*)(Cs + t * 256 + lane * 4);
        const float mu = wave_sum((v.x + v.y) + (v.z + v.w)) * (1.f / 256.f);
        const float d0 = v.x - mu, d1 = v.y - mu, d2 = v.z - mu, d3 = v.w - mu;
        const float rs = rsqrtf(wave_sum(d0 * d0 + d1 * d1 + d2 * d2 + d3 * d3) * (1.f / 256.f) + 1e-5f);
        const f32x4 g = *(const f32x4*)(p.in[I_LNG] + lane * 4), bb = *(const f32x4*)(p.in[I_LNB] + lane * 4);
        u32x2 w; w.x = pk2(siluf_(d0 * rs * g.x + bb.x), siluf_(d1 * rs * g.y + bb.y)); w.y = pk2(siluf_(d2 * rs * g.z + bb.z), siluf_(d3 * rs * g.w + bb.w));
        *(u32x2*)(MX + (size_t)(b * 2048 + t0 + t) * 1024 + 768 + lane * 4) = w; }
}
__device__ __forceinline__ void phase_ret_conv(const Params& p, LAS unsigned char* lds) {
    const int bid = blockIdx.x, G = gridDim.x;
    if (G >= 256) {
        if (bid < 192) retention_unit(p, lds, bid);
        else { for (int it = bid - 192; it < 1024; it += G - 192) conv_item(p, lds, it);
 }
    } else {
        for (int u = bid; u < 192; u += G) retention_unit(p, lds, u);
        for (int it = bid; it < 1024; it += G) conv_item(p, lds, it);
    }
}
__device__ __forceinline__ void phase_ret_out(const Params& p) {
    const int lane = tidx() & 63, gw = blockIdx.x * 8 + (tidx() >> 6), GW = gridDim.x * 8;
    const bf16_t* P = (const bf16_t*)(p.ws + WS_P); const bf16_t* YF = (const bf16_t*)(p.ws + WS_YRF); const bf16_t* YB = (const bf16_t*)(p.ws + WS_YRB); bf16_t* MX = (bf16_t*)(p.ws + WS_HM);
    for (int row0 = gw * 2; row0 < XR; row0 += GW * 2) {
#pragma unroll
        for (int ps = 0; ps < 3; ++ps) {
            const int s = ps * 64 + lane, rsel = s >= 96 ? 1 : 0, ch = (s - rsel * 96) * 8; const int row = row0 + rsel;
            const u32x4 yf = __builtin_nontemporal_load((const u32x4*)(YF + (size_t)row * 768 + ch)), yb = __builtin_nontemporal_load((const u32x4*)(YB + (size_t)row * 768 + ch)), gg = *(const u32x4*)(P + (size_t)row * PW + 1536 + ch);
            const unsigned yfw[4] = {yf.x, yf.y, yf.z, yf.w}, ybw[4] = {yb.x, yb.y, yb.z, yb.w}, ggw[4] = {gg.x, gg.y, gg.z, gg.w};
            float y[8]; float sm = 0.f;
#pragma unroll
            for (int e = 0; e < 4; ++e) { y[2 * e] = bflo(yfw[e]) + bflo(ybw[e]); y[2 * e + 1] = bfhi(yfw[e]) + bfhi(ybw[e]); sm += y[2 * e] + y[2 * e + 1]; }
            sm = red8(sm); sm += dppf<0x140>(sm);
            const float mu = sm * (1.f / 128.f); float q = 0.f;
#pragma unroll
            for (int e = 0; e < 8; ++e) { y[e] -= mu; q += y[e] * y[e]; }
            q = red8(q); q += dppf<0x140>(q);
            const float rs = rsqrtf(q * (1.f / 128.f) + 1e-5f);
            const f32x4 c0 = *(const f32x4*)(p.in[I_GNG] + ch), c1 = *(const f32x4*)(p.in[I_GNG] + ch + 4), d0 = *(const f32x4*)(p.in[I_GNB] + ch), d1 = *(const f32x4*)(p.in[I_GNB] + ch + 4);
            const float lg[8] = {c0.x, c0.y, c0.z, c0.w, c1.x, c1.y, c1.z, c1.w}, lb[8] = {d0.x, d0.y, d0.z, d0.w, d1.x, d1.y, d1.z, d1.w};
            float o8[8];
#pragma unroll
            for (int e = 0; e < 8; ++e) { const unsigned wg = ggw[e >> 1]; const float g1 = (e & 1) ? bfhi(wg) : bflo(wg); o8[e] = (y[e] * rs * lg[e] + lb[e]) * siluf_(g1); }
            u32x4 w; w.x = pk2(o8[0], o8[1]); w.y = pk2(o8[2], o8[3]); w.z = pk2(o8[4], o8[5]); w.w = pk2(o8[6], o8[7]);
            *(u32x4*)(MX + (size_t)row * 1024 + ch) = w;
        }
    }
}

__global__ void __launch_bounds__(512) hybrid_fwd(Params p) {
    extern __shared__ __attribute__((aligned(16))) unsigned char shm[];
    LAS unsigned char* lds = (LAS unsigned char*)shm;
    cg::grid_group grid = cg::this_grid();
    unsigned char* ws = p.ws;
    bf16_t* HM = (bf16_t*)(ws + WS_HM); bf16_t* PB = (bf16_t*)(ws + WS_P);
    const float* MODX = (const float*)(ws + WS_MODX); const float* MODC = (const float*)(ws + WS_MODC); float* CON = (float*)(ws + WS_CON);
    { volatile LAS unsigned* st0 = (volatile LAS unsigned*)(lds + (LDS_BYTES - 16)); if (tidx() < 4) st0[tidx()] = 0u; __syncthreads(); }
    const XcdBarrier xb = xcd_barrier_post((unsigned*)(ws + WS_BAR), (volatile LAS unsigned*)(lds + (LDS_BYTES - 16)));
    prep_mods(p, lds, blockIdx.x, gridDim.x);
    prep_transposes(p, lds, 6112, 6136, blockIdx.x, gridDim.x);
    prep_transposes(p, lds, 0, PREP_T_ABIN, blockIdx.x, gridDim.x);
    prep_fold_tables(p, lds, blockIdx.x, gridDim.x);
    xcd_barrier(xb);
    if (p.ws == nullptr) grid.sync();
    int vc;
    { volatile LAS unsigned* st0 = (volatile LAS unsigned*)(lds + (LDS_BYTES - 16));
      if (tidx() == 0) { const unsigned G = gridDim.x; bool ok = (G % 8u) == 0u; unsigned* bar = (unsigned*)(ws + WS_BAR);
          for (unsigned j = 0; j < 16; ++j) { const unsigned c = xb_ld(&bar[XB_XCNT(j)]); ok = ok && (j < 8 ? c == G / 8u : c == 0u); }
          st0[3] = ok ? (st0[2] * 8u + xb.x) : (unsigned)blockIdx.x; }
      __syncthreads(); vc = (int)st0[3]; }
    phase_modnorm(p, p.in[I_X], p.in[I_CTX], p.in[I_NMIXG], 0, 0, TOK);
    xcd_barrier(xb);
    { EpiAbIn E; E.P = PB; E.VTX = (bf16_t*)(ws + WS_VTX); E.VTC = (bf16_t*)(ws + WS_VTC);
      run_gemm(lds, HM, (const bf16_t*)(ws + WS_WABIN), TOK, NABIN, 1024, E, vc); }
    xcd_barrier(xb);
    phase_scan(p, lds);
    xcd_barrier(xb);
    phase_rwkv_out(p);
    phase_swc(p);
    xcd_barrier(xb);
    const int GG_ = gridDim.x, NC = GG_ >= 256 ? 64 : (GG_ >= 8 ? GG_ / 4 : 1), NX = GG_ - NC; const bool cwg = (int)blockIdx.x >= NX;
    float* SS = (float*)(ws + WS_SS); const float* SWC = (const float*)(ws + WS_SWC); bf16_t* HS = (bf16_t*)(ws + WS_SCR);
    { EpiResid E; E.basex = p.in[I_X]; E.basec = p.in[I_CTX]; E.outx = p.out; E.outc = CON; E.gatex = MODX + 2 * 1024; E.gatec = MODC + 2 * 1024;
      run_gemm(lds, HM, (const bf16_t*)(ws + WS_WABOUT), XR, 1024, 1024, E, vc); }
    xcd_barrier(xb);
    if (cwg) { EpiResidH E; E.base = p.in[I_CTX]; E.out = CON; E.gate = MODC + 2 * 1024; E.g = p.in[I_NFFNG]; E.scale = MODC + 4 * 1024; E.Hn = HS; E.SS = SS;
        run_gemm_ctx(lds, HM, (const bf16_t*)(ws + WS_WABOUT), 1024, 1024, E, NC, (int)blockIdx.x - NX); }
    else phase_modnorm(p, p.out, CON, p.in[I_NFFNG], 0, 3, XR, blockIdx.x, NX);
    xcd_barrier(xb);
    { EpiSwiglu E; E.Gh = PB; run_gemm(lds, HM, (const bf16_t*)(ws + WS_W13), XR, 5632, 1024, E, vc); }
    { EpiSwigluCtx E; E.Gh = PB; E.SS = SS; E.SW = SWC; run_gemm_ctx(lds, HS, (const bf16_t*)(ws + WS_W13), 5632, 1024, E, GG_, vc); }
    xcd_barrier(xb);
    { EpiResid E; E.basex = p.out; E.basec = CON; E.outx = p.out; E.outc = CON; E.gatex = MODX + 5 * 1024; E.gatec = MODC + 5 * 1024;
      run_gemm(lds, PB, (const bf16_t*)(ws + WS_W2), XR, 1024, 2816, E, vc); }
    xcd_barrier(xb);
    if (cwg) { EpiResidH E; E.base = CON; E.out = CON; E.gate = MODC + 5 * 1024; E.g = p.in[I_NMIXG] + 1024; E.scale = MODC + 6144 + 1 * 1024; E.Hn = HM; E.SS = SS + TOK;
        run_gemm_ctx(lds, PB, (const bf16_t*)(ws + WS_W2), 1024, 2816, E, NC, (int)blockIdx.x - NX); }
    else phase_modnorm(p, p.out, CON, p.in[I_NMIXG] + 1024, 1, 0, XR, blockIdx.x, NX);
    xcd_barrier(xb);
    { EpiCdIn E; E.O = PB; E.SS = SS + TOK; E.SW = SWC + 5632; run_gemm_cdin(lds, HM, (const bf16_t*)(ws + WS_WCDIN), E, vc); }
    xcd_barrier(xb);
    phase_ret_conv(p, lds);
    xcd_barrier(xb);
    phase_ret_out(p);
    xcd_barrier(xb);
    { EpiResid E; E.basex = p.out; E.basec = CON; E.outx = p.out; E.outc = CON; E.gatex = MODX + 16 * 6144 + 2 * 1024; E.gatec = MODC + 6144 + 2 * 1024;
      run_gemm(lds, HM, (const bf16_t*)(ws + WS_WCDOUT), XR, 1024, 1024, E, vc); }
    xcd_barrier(xb);
    phase_modnorm(p, p.out, CON, p.in[I_NFFNG] + 1024, 1, 3, XR);
    xcd_barrier(xb);
    { EpiSwiglu E; E.Gh = PB; run_gemm(lds, HM, (const bf16_t*)(ws + WS_W13) + (size_t)5632 * 1024, XR, 5632, 1024, E, vc); }
    xcd_barrier(xb);
    { EpiResid E; E.basex = p.out; E.basec = CON; E.outx = p.out; E.outc = CON; E.gatex = MODX + 16 * 6144 + 5 * 1024; E.gatec = MODC + 6144 + 5 * 1024;
      run_gemm(lds, PB, (const bf16_t*)(ws + WS_W2) + (size_t)1024 * 2816, XR, 1024, 2816, E, vc); }
    xcd_barrier(xb);
    phase_final_norm(p);
}

extern "C" void kernel_launch(void* const* d_in, const int* in_sizes, int n_in, void* d_out, int out_size, void* d_ws, size_t ws_size, hipStream_t stream) {
    static int grid_blocks = 0;
    if (grid_blocks == 0) {
        if (n_in != 35 || in_sizes[0] != XR * D || out_size != XR * D || ws_size < WS_END) { fprintf(stderr, "kernel_launch: unexpected shapes (n_in %d, in0 %d, out %d, ws %zu need %zu)\n", n_in, n_in > 0 ? in_sizes[0] : -1, out_size, ws_size, (size_t)WS_END); grid_blocks = -1; return; }
        int dev = 0, cus = 0, per_cu = 0;
        hipGetDevice(&dev); hipDeviceGetAttribute(&cus, hipDeviceAttributeMultiprocessorCount, dev);
        if (hipFuncSetAttribute((const void*)hybrid_fwd, hipFuncAttributeMaxDynamicSharedMemorySize, LDS_BYTES) != hipSuccess) { fprintf(stderr, "hipFuncSetAttribute failed\n"); grid_blocks = -1; return; }
        if (hipOccupancyMaxActiveBlocksPerMultiprocessor(&per_cu, (const void*)hybrid_fwd, NT, LDS_BYTES) != hipSuccess || per_cu < 1) { fprintf(stderr, "occupancy query failed (%d)\n", per_cu); (void)hipGetLastError(); per_cu = 1; }
        grid_blocks = cus * per_cu;
        fprintf(stderr, "kernel_launch: grid %d (cus %d x %d)\n", grid_blocks, cus, per_cu);
    }
    if (grid_blocks < 0) return;
    if (hipMemsetAsync((unsigned char*)d_ws + WS_BAR, 0, 16384, stream) != hipSuccess) { fprintf(stderr, "memset failed\n"); return; }
    Params p{};
    for (int i = 0; i < 35; ++i) p.in[i] = (const float*)d_in[i];
    p.out = (float*)d_out; p.ws = (unsigned char*)d_ws;
    void* args[] = {&p};
    hipError_t e = hipLaunchCooperativeKernel((const void*)hybrid_fwd, dim3(grid_blocks), dim3(NT), args, LDS_BYTES, stream);
    if (e != hipSuccess) fprintf(stderr, "cooperative launch failed: %s (grid %d)\n", hipGetErrorString(e), grid_blocks);
}
```
